# Optimizing an MI355X kernel written in HIP

```python
import math
import jax, jax.numpy as jnp
from jax import lax
import numpy as np

D_MODEL = 4096
BATCH = 2
SEQ = 8192
DEPTH = 2

CHUNK = 64
EPS = 1e-6
MASK_VALUE = -1e30
TINY = 1e-30

MLA_HEADS = 16
MLA_Q_RANK = 768
MLA_KV_RANK = 512
MLA_NOPE = 128
MLA_ROPE = 64
MLA_V = 128
ROPE_THETA = 10000.0
Q_BLOCK = 128

HG_HEADS = 8
HG_KDIM = 128
HG_VDIM = 128
HG_CHUNK = 16

CA_HEADS = 8
CA_HEAD_DIM = 128
CA_LEFT_CHUNKS = 8
CA_REL_CLIP = 256

MLA_WIDTH = MLA_HEADS * MLA_V
HG_WIDTH = HG_HEADS * HG_VDIM
CA_WIDTH = CA_HEADS * CA_HEAD_DIM
MIX_WIDTH = MLA_WIDTH + HG_WIDTH + CA_WIDTH
D_FF = ((8 * D_MODEL + 3 * 256 - 1) // (3 * 256)) * 256

IN_SIZES = (MLA_Q_RANK, MLA_KV_RANK, MLA_ROPE,
            HG_HEADS * HG_KDIM, HG_HEADS * HG_KDIM, HG_WIDTH, HG_WIDTH,
            CA_WIDTH, CA_WIDTH, CA_WIDTH)
D_IN = sum(IN_SIZES)
IN_OFFSETS = tuple(int(o) for o in np.cumsum(IN_SIZES)[:-1])

kernel_name = "hybrid_mla_hgrn2_chunkattn_block"


def rms_norm(x, g):
    xf = x.astype(jnp.float32)
    y = xf * lax.rsqrt(jnp.mean(xf * xf, axis=-1, keepdims=True) + EPS)
    return (y * g.astype(jnp.float32)).astype(x.dtype)


def rope_tables(positions):
    half = MLA_ROPE // 2
    inv_freq = jnp.exp(-math.log(ROPE_THETA) * 2.0 * jnp.arange(half, dtype=jnp.float32) / MLA_ROPE)
    ang = positions.astype(jnp.float32)[..., None] * inv_freq
    return jnp.cos(ang)[:, :, None, :], jnp.sin(ang)[:, :, None, :]


def apply_rope(t, cos, sin):
    half = t.shape[-1] // 2
    tf = t.astype(jnp.float32)
    t1, t2 = tf[..., :half], tf[..., half:]
    return jnp.concatenate([t1 * cos - t2 * sin, t1 * sin + t2 * cos], axis=-1).astype(t.dtype)


def mla_mixer(c_q, c_kv, k_rope, q_norm, kv_norm, w_uq, w_ukv, out_norm, cos, sin):
    B, S, _ = c_q.shape
    q = (rms_norm(c_q, q_norm) @ w_uq).reshape(B, S, MLA_HEADS, MLA_NOPE + MLA_ROPE)
    kv = (rms_norm(c_kv, kv_norm) @ w_ukv).reshape(B, S, MLA_HEADS, MLA_NOPE + MLA_V)
    q_nope = q[..., :MLA_NOPE]
    q_pe = apply_rope(q[..., MLA_NOPE:], cos, sin)
    k_nope, v = kv[..., :MLA_NOPE], kv[..., MLA_NOPE:]
    k_pe = apply_rope(k_rope[:, :, None, :], cos, sin)[:, :, 0, :]
    scale = (MLA_NOPE + MLA_ROPE) ** -0.5
    nb = S // Q_BLOCK
    qn_blocks = q_nope.reshape(B, nb, Q_BLOCK, MLA_HEADS, MLA_NOPE).transpose(1, 0, 2, 3, 4)
    qp_blocks = q_pe.reshape(B, nb, Q_BLOCK, MLA_HEADS, MLA_ROPE).transpose(1, 0, 2, 3, 4)
    key_chunk = jnp.arange(S) // CHUNK

    def one_block(args):
        qn, qp, blk = args
        s = (jnp.einsum('bqhd,bkhd->bhqk', qn, k_nope)
             + jnp.einsum('bqhr,bkr->bhqk', qp, k_pe)).astype(jnp.float32) * scale
        q_chunk = (blk * Q_BLOCK + jnp.arange(Q_BLOCK)) // CHUNK
        mask = key_chunk[None, :] <= q_chunk[:, None]
        s = jnp.where(mask[None, None], s, MASK_VALUE)
        p = jax.nn.softmax(s, axis=-1).astype(v.dtype)
        return jnp.einsum('bhqk,bkhd->bqhd', p, v)

    o = lax.map(one_block, (qn_blocks, qp_blocks, jnp.arange(nb)))
    o = o.transpose(1, 0, 2, 3, 4).reshape(B, S, MLA_WIDTH)
    return rms_norm(o, out_norm)


def hgrn2_mixer(q, f_pre, i, g, lb, out_norm):
    B, S, _ = q.shape
    L = HG_CHUNK
    nc = S // L
    dtype = q.dtype
    q = jax.nn.silu(q).astype(jnp.float32)
    fp = f_pre.astype(jnp.float32)
    f = lb + (1.0 - lb) * jax.nn.sigmoid(fp)
    log_f = jnp.log(jnp.maximum(f, TINY))
    k = (1.0 - lb) * jax.nn.sigmoid(-fp)

    def heads(t, d):
        return t.reshape(B, nc, L, HG_HEADS, d).transpose(0, 3, 1, 2, 4)

    qh, kh, lfh = heads(q, HG_KDIM), heads(k, HG_KDIM), heads(log_f, HG_KDIM)
    vh = heads(i.astype(jnp.float32), HG_VDIM)
    b = jnp.cumsum(lfh, axis=3)
    causal = jnp.tril(jnp.ones((L, L), dtype=bool))[:, :, None]
    diff = b[..., :, None, :] - b[..., None, :, :]
    decay = jnp.where(causal, jnp.exp(jnp.where(causal, diff, 0.0)), 0.0)
    A = jnp.sum(qh[..., :, None, :] * kh[..., None, :, :] * decay, axis=-1)
    o_intra = jnp.einsum('bhnij,bhnjv->bhniv', A, vh)

    b_last = b[..., -1:, :]
    k_dec = kh * jnp.exp(b_last - b)
    q_dec = qh * jnp.exp(b)
    chunk_decay = jnp.exp(b_last[..., 0, :])

    def step(state, xs):
        qd, kd, vc, cd = xs
        out = jnp.einsum('bhlk,bhkv->bhlv', qd, state)
        state = cd[..., None] * state + jnp.einsum('bhlk,bhlv->bhkv', kd, vc)
        return state, out

    xs = (jnp.moveaxis(q_dec, 2, 0), jnp.moveaxis(k_dec, 2, 0),
          jnp.moveaxis(vh, 2, 0), jnp.moveaxis(chunk_decay, 2, 0))
    state0 = jnp.zeros((B, HG_HEADS, HG_KDIM, HG_VDIM), jnp.float32)
    _, o_inter = lax.scan(step, state0, xs)
    o = o_intra + jnp.moveaxis(o_inter, 0, 2)
    o = o.transpose(0, 2, 3, 1, 4).reshape(B, S, HG_HEADS, HG_VDIM).astype(dtype)
    o = rms_norm(o, out_norm.reshape(HG_HEADS, HG_VDIM)).reshape(B, S, HG_WIDTH)
    return o * jax.nn.silu(g)


def chunk_attn_mixer(q, k, v, rel_bias, out_norm):
    B, S, _ = q.shape
    nc = S // CHUNK
    W = CA_LEFT_CHUNKS + 1

    def heads(t):
        return t.reshape(B, nc, CHUNK, CA_HEADS, CA_HEAD_DIM)

    qc, kc, vc = heads(q), heads(k), heads(v)
    pad = ((0, 0), (CA_LEFT_CHUNKS, 0), (0, 0), (0, 0), (0, 0))
    kp, vp = jnp.pad(kc, pad), jnp.pad(vc, pad)
    k_band = jnp.concatenate([kp[:, w:w + nc] for w in range(W)], axis=2)
    v_band = jnp.concatenate([vp[:, w:w + nc] for w in range(W)], axis=2)
    s = jnp.einsum('bnqhd,bnkhd->bhnqk', qc, k_band).astype(jnp.float32) * (CA_HEAD_DIM ** -0.5)
    a = jnp.arange(CHUNK)
    kidx = jnp.arange(W * CHUNK)
    dist = (CA_LEFT_CHUNKS * CHUNK + a[:, None]) - kidx[None, :]
    bucket = jnp.clip(dist, -CA_REL_CLIP, CA_REL_CLIP) + CA_REL_CLIP
    bias = rel_bias[:, bucket].astype(jnp.float32)
    key_chunk = jnp.arange(nc)[:, None] - CA_LEFT_CHUNKS + kidx[None, :] // CHUNK
    valid = key_chunk >= 0
    s = s + bias[None, :, None]
    s = jnp.where(valid[None, None, :, None, :], s, MASK_VALUE)
    p = jax.nn.softmax(s, axis=-1).astype(v.dtype)
    o = jnp.einsum('bhnqk,bnkhd->bnqhd', p, v_band).reshape(B, S, CA_WIDTH)
    return rms_norm(o, out_norm)


def setup_inputs(seed: int = 0) -> dict:
    key = jax.random.key(seed)
    ks = jax.random.split(key, 24)
    f32 = jnp.float32

    def w(k, shape, fan_in):
        return jax.random.normal(k, shape, f32) * (fan_in ** -0.5)

    def gain(k, shape):
        return 1.0 + 0.05 * jax.random.normal(k, shape, f32)

    x = jax.random.normal(ks[0], (BATCH, SEQ, D_MODEL), f32)
    offset = jax.random.randint(ks[1], (BATCH, 1), 0, 4096, dtype=jnp.int32)
    positions = (offset + jnp.arange(SEQ, dtype=jnp.int32)[None, :]).astype(jnp.int32)
    return {
        "x": x,
        "positions": positions,
        "attn_pre_norm": gain(ks[2], (DEPTH, D_MODEL)),
        "attn_post_norm": gain(ks[3], (DEPTH, D_MODEL)),
        "w_in": w(ks[4], (DEPTH, D_MODEL, D_IN), D_MODEL),
        "mla_q_norm": gain(ks[5], (DEPTH, MLA_Q_RANK)),
        "mla_kv_norm": gain(ks[6], (DEPTH, MLA_KV_RANK)),
        "w_uq": w(ks[7], (DEPTH, MLA_Q_RANK, MLA_HEADS * (MLA_NOPE + MLA_ROPE)), MLA_Q_RANK),
        "w_ukv": w(ks[8], (DEPTH, MLA_KV_RANK, MLA_HEADS * (MLA_NOPE + MLA_V)), MLA_KV_RANK),
        "mla_out_norm": gain(ks[9], (DEPTH, MLA_WIDTH)),
        "hg_lower_bounds": jax.random.normal(ks[10], (DEPTH, HG_HEADS * HG_KDIM), f32),
        "hg_out_norm": gain(ks[11], (DEPTH, HG_WIDTH)),
        "ca_rel_bias": 0.5 * jax.random.normal(ks[12], (DEPTH, CA_HEADS, 2 * CA_REL_CLIP + 1), f32),
        "ca_out_norm": gain(ks[13], (DEPTH, CA_WIDTH)),
        "w_out": w(ks[14], (DEPTH, MIX_WIDTH, D_MODEL), MIX_WIDTH),
        "ffn_pre_norm": gain(ks[15], (DEPTH, D_MODEL)),
        "ffn_post_norm": gain(ks[16], (DEPTH, D_MODEL)),
        "w_gate": w(ks[17], (DEPTH, D_MODEL, D_FF), D_MODEL),
        "w_up": w(ks[18], (DEPTH, D_MODEL, D_FF), D_MODEL),
        "w_down": w(ks[19], (DEPTH, D_FF, D_MODEL), D_FF),
    }


def reference(x, positions, attn_pre_norm, attn_post_norm, w_in, mla_q_norm, mla_kv_norm,
              w_uq, w_ukv, mla_out_norm, hg_lower_bounds, hg_out_norm, ca_rel_bias,
              ca_out_norm, w_out, ffn_pre_norm, ffn_post_norm, w_gate, w_up, w_down):
    cos, sin = rope_tables(positions)
    p = jax.nn.softmax(hg_lower_bounds.astype(jnp.float32), axis=0)
    lower_bounds = jnp.cumsum(p, axis=0) - p[0]
    for l in range(DEPTH):
        h = rms_norm(x, attn_pre_norm[l]) @ w_in[l]
        cq, ckv, kr, hq, hf, hi, hg, aq, ak, av = jnp.split(h, IN_OFFSETS, axis=-1)
        o_mla = mla_mixer(cq, ckv, kr, mla_q_norm[l], mla_kv_norm[l], w_uq[l], w_ukv[l],
                          mla_out_norm[l], cos, sin)
        o_hg = hgrn2_mixer(hq, hf, hi, hg, lower_bounds[l], hg_out_norm[l])
        o_ca = chunk_attn_mixer(aq, ak, av, ca_rel_bias[l], ca_out_norm[l])
        y = jnp.concatenate([o_mla, o_hg.astype(o_mla.dtype), o_ca], axis=-1) @ w_out[l]
        x = x + rms_norm(y, attn_post_norm[l])
        hf2 = rms_norm(x, ffn_pre_norm[l])
        y = (jax.nn.silu(hf2 @ w_gate[l]) * (hf2 @ w_up[l])) @ w_down[l]
        x = x + rms_norm(y, ffn_post_norm[l])
    return x
```

```cpp
#include <hip/hip_runtime.h>
#include <cstdio>
#include <cstdint>
namespace pg8 {
#define PG8_LAS __attribute__((address_space(3)))
#define PG8_GAS __attribute__((address_space(1)))
typedef unsigned short bf16_t;
typedef short bf16x8 __attribute__((ext_vector_type(8)));
typedef float f32x4 __attribute__((ext_vector_type(4)));
typedef unsigned u32x4 __attribute__((ext_vector_type(4)));
constexpr int BM = 256, BK = 64, HALF = 128, HTB = HALF * BK * 2  , STAGE_BYTES = 8 * HTB, NXCD = 8, WGM = 8;

__host__ __device__ __forceinline__ int lds_byte(int r, int c) { const int st = (r >> 4) * 2 + (c >> 5), rr = r & 15, cc = c & 31, ob = rr * 64 + cc * 2; return st * 1024 + (ob ^ (((ob >> 9) & 1) << 5)); }
__host__ __device__ __forceinline__ void stage_rc(int b, int& R, int& C) { const int st = b / 1024, sb = b % 1024, swz = sb ^ (((sb >> 9) & 1) << 5); R = (st >> 1) * 16 + swz / 64; C = (st & 1) * 32 + (swz % 64) / 2; }
__host__ __device__ __forceinline__ int perm32(int rho) { const int n = rho >> 4, i = rho & 15; return 8 * (i >> 2) + 4 * n + (i & 3); }

struct Unit { int pm, pn; };
struct Gemm { const PG8_GAS bf16_t* A; const PG8_GAS bf16_t* Bt; int M, N, K; };

struct StaticOrder {
    int nM, nN, nwg, G, c;
    __host__ __device__ void init(int M, int N, int G_, int c_) { nM = M / BM; nN = N / BM; nwg = nM * nN; G = G_; c = c_; }
    __host__ __device__ bool next(int i, Unit& u) const {
        const long L = (long)i * G + c; if (L >= nwg) return false;
        int wgid = (int)L; { const int q = nwg / NXCD, r = nwg % NXCD, xcd = wgid % NXCD, off = wgid / NXCD; wgid = (xcd < r ? xcd * (q + 1) : r * (q + 1) + (xcd - r) * q) + off; }
        const int nig = WGM * nN, gid = wgid / nig, fm = gid * WGM, gsz = (nM - fm) < WGM ? (nM - fm) : WGM;
        u.pm = fm + ((wgid % nig) % gsz); u.pn = (wgid % nig) / gsz; return true;
    }
    __device__ __forceinline__ void a_ready(const Unit&) const {}
    __device__ __forceinline__ void done(const Unit&) const {}
};


__device__ __forceinline__ unsigned cvt_pk_bf16(float lo, float hi) { unsigned r; asm volatile("v_cvt_pk_bf16_f32 %0, %1, %2" : "=v"(r) : "v"(lo), "v"(hi)); return r; }
__device__ __forceinline__ u32x4 pack8(const f32x4 v0, const f32x4 v1) { u32x4 w; w.x = cvt_pk_bf16(v0[0], v0[1]); w.y = cvt_pk_bf16(v0[2], v0[3]); w.z = cvt_pk_bf16(v1[0], v1[1]); w.w = cvt_pk_bf16(v1[2], v1[3]); return w; }

struct EpiF32 {
    static constexpr bool PERM = false, AFTER_DRAIN = false;
    PG8_GAS float* C; int ldc;
    __device__ __forceinline__ void operator()(const f32x4 (&acc)[2][2][4][2], const Unit& u, int wr, int wc, int fr, int fq) const {
        const int row0 = u.pm * BM + wr * 64 + fr, col0 = u.pn * BM + wc * 32 + 4 * fq;
#pragma unroll
        for (int ai = 0; ai < 2; ++ai)
#pragma unroll
            for (int m = 0; m < 4; ++m) { PG8_GAS float* rowp = C + (size_t)(row0 + ai * HALF + m * 16) * ldc + col0;
#pragma unroll
                for (int bj = 0; bj < 2; ++bj)
#pragma unroll
                    for (int n = 0; n < 2; ++n) *(PG8_GAS f32x4*)(rowp + bj * HALF + n * 16) = acc[ai][bj][m][n]; }
    }
};
struct EpiH {
    static constexpr bool PERM = true, AFTER_DRAIN = false;
    PG8_GAS bf16_t* O; int ldc; const PG8_GAS float* rs;
    __device__ __forceinline__ void operator()(const f32x4 (&acc)[2][2][4][2], const Unit& u, int wr, int wc, int fr, int fq) const {
        const int row0 = u.pm * BM + wr * 64 + fr, col0 = u.pn * BM + wc * 32 + 8 * fq;
#pragma unroll
        for (int ai = 0; ai < 2; ++ai)
#pragma unroll
            for (int m = 0; m < 4; ++m) { const int row = row0 + ai * HALF + m * 16; PG8_GAS bf16_t* rowp = O + (size_t)row * ldc + col0; const float sc = rs ? rs[row] : 1.0f;
#pragma unroll
                for (int bj = 0; bj < 2; ++bj) __builtin_nontemporal_store(pack8(acc[ai][bj][m][0] * sc, acc[ai][bj][m][1] * sc), (PG8_GAS u32x4*)(rowp + bj * HALF)); }
    }
};
struct EpiQ {
    static constexpr bool PERM = true, AFTER_DRAIN = false;
    PG8_GAS bf16_t* Q; const PG8_GAS float* rope; float qs;
    __device__ __forceinline__ void operator()(const f32x4 (&acc)[2][2][4][2], const Unit& u, int wr, int wc, int fr, int fq) const {
        const int row0 = u.pm * BM + wr * 64 + fr;
#pragma unroll
        for (int ai = 0; ai < 2; ++ai)
#pragma unroll
            for (int m = 0; m < 4; ++m) { const int row = row0 + ai * HALF + m * 16;
#pragma unroll
                for (int bj = 0; bj < 2; ++bj) {
                    f32x4 v0 = acc[ai][bj][m][0] * qs, v1 = acc[ai][bj][m][1] * qs;
                    PG8_GAS bf16_t* dst;
                    if (u.pn < 8) { const int h = 2 * u.pn + bj; dst = Q + (size_t)row * 3072 + h * 192 + wc * 32 + 8 * fq; }
                    else { const int cr = (u.pn - 8) * 256 + bj * HALF + wc * 32 + 8 * fq, h = cr >> 6, pos = cr & 63;
                        const PG8_GAS float* cs = rope + (size_t)row * 64 + pos;
                        const f32x4 c0 = *(const PG8_GAS f32x4*)cs, c1 = *(const PG8_GAS f32x4*)(cs + 4);
                        const f32x4 r0 = (f32x4){v0[0] * c0[0] - v0[1] * c0[1], v0[0] * c0[1] + v0[1] * c0[0], v0[2] * c0[2] - v0[3] * c0[3], v0[2] * c0[3] + v0[3] * c0[2]};
                        const f32x4 r1 = (f32x4){v1[0] * c1[0] - v1[1] * c1[1], v1[0] * c1[1] + v1[1] * c1[0], v1[2] * c1[2] - v1[3] * c1[3], v1[2] * c1[3] + v1[3] * c1[2]};
                        v0 = r0; v1 = r1; dst = Q + (size_t)row * 3072 + h * 192 + 128 + pos; }
                    *(PG8_GAS u32x4*)dst = pack8(v0, v1); } }
    }
};
struct EpiKV {
    static constexpr bool PERM = true, AFTER_DRAIN = false;
    PG8_GAS bf16_t* KN; PG8_GAS bf16_t* V;
    __device__ __forceinline__ void operator()(const f32x4 (&acc)[2][2][4][2], const Unit& u, int wr, int wc, int fr, int fq) const {
        const int row0 = u.pm * BM + wr * 64 + fr, col0 = u.pn * 128 + wc * 32 + 8 * fq;
#pragma unroll
        for (int ai = 0; ai < 2; ++ai)
#pragma unroll
            for (int m = 0; m < 4; ++m) { const size_t off = (size_t)(row0 + ai * HALF + m * 16) * 2048 + col0;
                *(PG8_GAS u32x4*)(KN + off) = pack8(acc[ai][0][m][0], acc[ai][0][m][1]);
                *(PG8_GAS u32x4*)(V + off) = pack8(acc[ai][1][m][0], acc[ai][1][m][1]); }
    }
};
__device__ __forceinline__ float silu_mul(float g, float up) { return g * __builtin_amdgcn_rcpf(1.0f + __builtin_amdgcn_exp2f(-1.4426950408889634f * g)) * up; }
struct EpiSwiGLU {
    static constexpr bool PERM = true, AFTER_DRAIN = false;
    PG8_GAS bf16_t* ACT; int ldc; const PG8_GAS float* rs;
    __device__ __forceinline__ void operator()(const f32x4 (&acc)[2][2][4][2], const Unit& u, int wr, int wc, int fr, int fq) const {
        const int row0 = u.pm * BM + wr * 64 + fr, col0 = u.pn * 128 + wc * 32 + 8 * fq;
#pragma unroll
        for (int ai = 0; ai < 2; ++ai)
#pragma unroll
            for (int m = 0; m < 4; ++m) { const int row = row0 + ai * HALF + m * 16; const float sc = rs[row];
                f32x4 r0, r1;
#pragma unroll
                for (int j = 0; j < 4; ++j) { r0[j] = silu_mul(acc[ai][0][m][0][j] * sc, acc[ai][1][m][0][j] * sc); r1[j] = silu_mul(acc[ai][0][m][1][j] * sc, acc[ai][1][m][1][j] * sc); }
                __builtin_nontemporal_store(pack8(r0, r1), (PG8_GAS u32x4*)(ACT + (size_t)row * ldc + col0)); }
    }
};

template <class Epi, class Sched, bool ALIGN_EPI = false, bool SP2 = false>
__device__ __forceinline__ void gemm_phase(PG8_LAS unsigned char* lds, const Gemm g, const Sched& S, const Epi& E, const int tid_in) {
    int tid_ = tid_in; asm volatile("" : "+v"(tid_));
    const int tid = tid_, wid = __builtin_amdgcn_readfirstlane(tid >> 6), lane = tid & 63, wr = wid >> 2, wc = wid & 3, fr = lane & 15, fq = lane >> 4;
    const int K = g.K, nt = K / BK;
    unsigned voffA[2], voffB[2];
#pragma unroll
    for (int i = 0; i < 2; ++i) { int R, C; stage_rc(tid * 16 + i * 8192, R, C); const int Rb = Epi::PERM ? ((R & ~31) + perm32(R & 31)) : R;
        voffA[i] = (unsigned)(R * K + C) * 2u; voffB[i] = (unsigned)(Rb * K + C) * 2u; }
    const size_t kstep = (size_t)(BK * 2);
    const size_t hstep = (size_t)HALF * K * 2;
    const size_t tstep = 2 * hstep;
    const unsigned ldsw = (unsigned)wid * 1024u;
    const int aoff = lds_byte(wr * 64 + fr, fq * 8), boff = lds_byte(wc * 32 + fr, fq * 8);
#define PG8_SA(b, h) (((b) * 2 + (h)) * HTB)
#define PG8_SB(b, h) ((4 + (b) * 2 + (h)) * HTB)
#define PG8_STAGE(bufoff, gbase, voff) do { _Pragma("unroll") for (int _i = 0; _i < 2; ++_i) \
        __builtin_amdgcn_global_load_lds((const PG8_GAS unsigned*)((const PG8_GAS char*)(gbase) + (voff)[_i]), (PG8_LAS unsigned*)(lds + (bufoff) + ldsw + _i * 8192), 16, 0, 0); } while (0)
#define PG8_LDA(dst, b, h) do { _Pragma("unroll") for (int m = 0; m < 4; ++m) _Pragma("unroll") for (int k = 0; k < 2; ++k) dst[m][k] = *(const PG8_LAS bf16x8*)(lds + PG8_SA(b, h) + aoff + m * 2048 + k * 1024); } while (0)
#define PG8_LDB(dst, b, h) do { _Pragma("unroll") for (int n = 0; n < 2; ++n) _Pragma("unroll") for (int k = 0; k < 2; ++k) dst[n][k] = *(const PG8_LAS bf16x8*)(lds + PG8_SB(b, h) + boff + n * 2048 + k * 1024); } while (0)
#define PG8_MMA(ai, bj, At, Bt) do { __builtin_amdgcn_s_setprio(1); _Pragma("unroll") for (int m = 0; m < 4; ++m) _Pragma("unroll") for (int n = 0; n < 2; ++n) _Pragma("unroll") for (int k = 0; k < 2; ++k) \
        acc[ai][bj][m][n] = __builtin_amdgcn_mfma_f32_16x16x32_bf16(Bt[n][k], At[m][k], acc[ai][bj][m][n], 0, 0, 0); __builtin_amdgcn_s_setprio(0); } while (0)
#define PG8_WAIT_V(n) asm volatile("s_waitcnt vmcnt(" #n ")" ::: "memory")
#define PG8_WAIT_L(n) asm volatile("s_waitcnt lgkmcnt(" #n ")" ::: "memory")
#define PG8_BAR __builtin_amdgcn_s_barrier()
#define PG8_SCHED __builtin_amdgcn_sched_barrier(0)
    Unit cur, nxt; int ui = 0;
    if (!S.next(0, cur)) return;
    f32x4 acc[2][2][4][2];
    float zf_ = 0.f; asm volatile("" : "+v"(zf_));
#pragma unroll
    for (int a = 0; a < 2; ++a)
#pragma unroll
        for (int b = 0; b < 2; ++b)
#pragma unroll
            for (int m = 0; m < 4; ++m)
#pragma unroll
                for (int n = 0; n < 2; ++n) acc[a][b][m][n] = (f32x4){zf_, zf_, zf_, zf_};
    bf16x8 At[4][2], B0[2][2], B1[2][2];
    const PG8_GAS char* cA = (const PG8_GAS char*)g.A + (size_t)cur.pm * tstep; const PG8_GAS char* cB = (const PG8_GAS char*)g.Bt + (size_t)cur.pn * tstep;
    S.a_ready(cur);
    if constexpr (SP2) {
        PG8_STAGE(PG8_SB(0, 0), cB, voffB); PG8_STAGE(PG8_SB(0, 1), cB + hstep, voffB); PG8_STAGE(PG8_SA(0, 0), cA, voffA); PG8_STAGE(PG8_SA(0, 1), cA + hstep, voffA);
        if (wr == 1) PG8_BAR;
        PG8_WAIT_V(2); PG8_BAR;
        PG8_STAGE(PG8_SB(1, 0), cB + kstep, voffB); PG8_STAGE(PG8_SA(1, 0), cA + kstep, voffA); PG8_STAGE(PG8_SB(1, 1), cB + hstep + kstep, voffB);
        PG8_WAIT_V(6); PG8_BAR;
    } else {
        PG8_STAGE(PG8_SB(0, 0), cB, voffB); PG8_STAGE(PG8_SA(0, 0), cA, voffA); PG8_STAGE(PG8_SB(0, 1), cB + hstep, voffB); PG8_STAGE(PG8_SA(0, 1), cA + hstep, voffA);
        if (wr == 1) PG8_BAR;
        PG8_WAIT_V(4); PG8_BAR;
        PG8_STAGE(PG8_SB(1, 0), cB + kstep, voffB); PG8_STAGE(PG8_SA(1, 0), cA + kstep, voffA); PG8_STAGE(PG8_SB(1, 1), cB + hstep + kstep, voffB);
        PG8_WAIT_V(6); PG8_BAR;
    }
    for (;;) {
        const bool has_next = S.next(ui + 1, nxt);
        const PG8_GAS char* nA = has_next ? (const PG8_GAS char*)g.A + (size_t)nxt.pm * tstep : cA; const PG8_GAS char* nB = has_next ? (const PG8_GAS char*)g.Bt + (size_t)nxt.pn * tstep : cB;
        for (int t = 0; t < nt; t += 2) {
            const bool last = (t == nt - 2);
            const PG8_GAS char* a1 = cA + (size_t)(t + 1) * kstep;
            const PG8_GAS char* a2 = last ? nA : cA + (size_t)(t + 2) * kstep; const PG8_GAS char* b2 = last ? nB : cB + (size_t)(t + 2) * kstep;
            const PG8_GAS char* a3 = a2 + kstep; const PG8_GAS char* b3 = b2 + kstep;
            if (last && has_next) S.a_ready(nxt);
            if constexpr (SP2) {
            PG8_LDB(B0, 0, 0); PG8_LDB(B1, 0, 1); PG8_SCHED; PG8_LDA(At, 0, 0); PG8_STAGE(PG8_SA(1, 1), a1 + hstep, voffA);
            PG8_WAIT_V(8); PG8_WAIT_L(0); PG8_BAR; PG8_MMA(0, 0, At, B0); PG8_MMA(0, 1, At, B1); PG8_BAR; PG8_SCHED;
            PG8_LDA(At, 0, 1); PG8_STAGE(PG8_SB(0, 0), b2, voffB); PG8_STAGE(PG8_SB(0, 1), b2 + hstep, voffB); PG8_STAGE(PG8_SA(0, 0), a2, voffA);
            PG8_WAIT_V(8); PG8_WAIT_L(0); PG8_BAR; PG8_MMA(1, 0, At, B0); PG8_MMA(1, 1, At, B1); PG8_BAR; PG8_SCHED;
            PG8_LDB(B0, 1, 0); PG8_LDB(B1, 1, 1); PG8_SCHED; PG8_LDA(At, 1, 0); PG8_STAGE(PG8_SA(0, 1), a2 + hstep, voffA);
            PG8_WAIT_V(8); PG8_WAIT_L(0); PG8_BAR; PG8_MMA(0, 0, At, B0); PG8_MMA(0, 1, At, B1); PG8_BAR; PG8_SCHED;
            PG8_LDA(At, 1, 1); PG8_STAGE(PG8_SB(1, 0), b3, voffB); PG8_STAGE(PG8_SB(1, 1), b3 + hstep, voffB); PG8_STAGE(PG8_SA(1, 0), a3, voffA);
            PG8_WAIT_V(8); PG8_WAIT_L(0); PG8_BAR; PG8_MMA(1, 0, At, B0); PG8_MMA(1, 1, At, B1); PG8_BAR; PG8_SCHED;
            } else {
            PG8_LDB(B0, 0, 0); PG8_SCHED; PG8_LDA(At, 0, 0); PG8_STAGE(PG8_SA(1, 1), a1 + hstep, voffA);
            PG8_WAIT_L(8); PG8_BAR; PG8_WAIT_L(0); PG8_MMA(0, 0, At, B0); PG8_BAR; PG8_SCHED;
            PG8_LDB(B1, 0, 1); PG8_STAGE(PG8_SB(0, 0), b2, voffB);
            PG8_BAR; PG8_WAIT_L(0); PG8_MMA(0, 1, At, B1); PG8_BAR;
            PG8_LDA(At, 0, 1); PG8_STAGE(PG8_SA(0, 0), a2, voffA);
            PG8_BAR; PG8_WAIT_L(0); PG8_MMA(1, 0, At, B0); PG8_BAR; PG8_SCHED;
            PG8_STAGE(PG8_SB(0, 1), b2 + hstep, voffB);
            PG8_WAIT_V(6); PG8_BAR; PG8_MMA(1, 1, At, B1); PG8_BAR;
            PG8_LDB(B0, 1, 0); PG8_SCHED; PG8_LDA(At, 1, 0); PG8_STAGE(PG8_SA(0, 1), a2 + hstep, voffA);
            PG8_WAIT_L(8); PG8_BAR; PG8_WAIT_L(0); PG8_MMA(0, 0, At, B0); PG8_BAR; PG8_SCHED;
            PG8_LDB(B1, 1, 1); PG8_STAGE(PG8_SB(1, 0), b3, voffB);
            PG8_BAR; PG8_WAIT_L(0); PG8_MMA(0, 1, At, B1); PG8_BAR;
            PG8_LDA(At, 1, 1); PG8_STAGE(PG8_SA(1, 0), a3, voffA);
            PG8_BAR; PG8_WAIT_L(0); PG8_MMA(1, 0, At, B0); PG8_BAR; PG8_SCHED;
            PG8_STAGE(PG8_SB(1, 1), b3 + hstep, voffB);
            PG8_WAIT_V(6); PG8_BAR; PG8_MMA(1, 1, At, B1); PG8_BAR;
            }
        }
        if constexpr (ALIGN_EPI) { if (wr == 0) PG8_BAR; }
        if constexpr (!Epi::AFTER_DRAIN) { E(acc, cur, wr, wc, fr, fq); S.done(cur); }
        if (!has_next) break;
#pragma unroll
        for (int a = 0; a < 2; ++a)
#pragma unroll
            for (int b = 0; b < 2; ++b)
#pragma unroll
                for (int m = 0; m < 4; ++m)
#pragma unroll
                    for (int n = 0; n < 2; ++n) acc[a][b][m][n] = (f32x4){zf_, zf_, zf_, zf_};
        cur = nxt; cA = nA; cB = nB; ++ui;
        if constexpr (ALIGN_EPI) { if (wr == 1) PG8_BAR; }
    }
    PG8_WAIT_V(0);
    if constexpr (!ALIGN_EPI) { if (wr == 0) PG8_BAR; }
    PG8_BAR;
    if constexpr (Epi::AFTER_DRAIN) { E.fused(acc, cur, wr, wc, fr, fq, lds, wid, lane); S.done(cur); }
#undef PG8_SA
#undef PG8_SB
#undef PG8_STAGE
#undef PG8_LDA
#undef PG8_LDB
#undef PG8_MMA
#undef PG8_WAIT_V
#undef PG8_WAIT_L
#undef PG8_BAR
#undef PG8_SCHED
}
}


constexpr int NWAVES = 8;
constexpr int BATCH = 2, SEQ = 8192, M = BATCH * SEQ, DM = 4096, DEPTH = 2;
constexpr int D_IN = 8512, D_IN_PAD = 8704, DFF = 11008;
constexpr int OFF_CQ = 0, OFF_CKV = 768, OFF_KR = 1280, OFF_HQ = 1344, OFF_HF = 2368, OFF_HI = 3392, OFF_HG = 4416, OFF_AQ = 5440, OFF_AK = 6464, OFF_AV = 7488;
constexpr float EPS = 1e-6f;
constexpr float LOG2E = 1.4426950408889634f;
constexpr int NPH = 1 + 10 * DEPTH;
#ifndef MK_PER_PHASE
#define MK_PER_PHASE 0
#endif

constexpr size_t MiB = 1u << 20;
constexpr size_t WS_CTL = 0, CTL_ZERO_BYTES = 1 * MiB;
constexpr size_t WS_ROPE = 2 * MiB;
constexpr size_t WS_LB = 6 * MiB;
constexpr size_t WS_WIN = 8 * MiB, WS_WUQ = 76 * MiB, WS_WUKV = 81 * MiB, WS_WOUT = 85 * MiB, WS_WGU = 117 * MiB, WS_WD = 289 * MiB;
constexpr size_t WS_XN = 375 * MiB;
constexpr size_t WS_H = 503 * MiB, WS_CQN = 775 * MiB, WS_CKVN = 799 * MiB, WS_KPE = 815 * MiB, WS_ACT = 503 * MiB;
constexpr size_t WS_Q = 847 * MiB, WS_KN = 943 * MiB, WS_V = 1007 * MiB, WS_Y = 847 * MiB;
constexpr size_t WS_MIXRAW = 1103 * MiB;
constexpr size_t WS_ST = 1359 * MiB;
constexpr size_t WS_QG = 1487 * MiB;
constexpr size_t WS_DL = 1519 * MiB;
constexpr size_t WS_MIX = 1520 * MiB;
constexpr size_t WS_RS1 = 1648 * MiB, WS_RS2 = 1649 * MiB;
constexpr size_t WS_END = 1650 * MiB;
static_assert(WS_WIN + (size_t)D_IN_PAD * DM * 2 <= WS_WUQ && WS_WUQ + (size_t)3072 * 768 * 2 <= WS_WUKV && WS_WUKV + (size_t)4096 * 512 * 2 <= WS_WOUT && WS_WOUT + (size_t)DM * DM * 2 <= WS_WGU &&
              WS_WGU + (size_t)2 * DFF * DM * 2 <= WS_WD && WS_WD + (size_t)DM * DFF * 2 <= WS_XN && WS_XN + (size_t)M * DM * 2 <= WS_H && WS_H + (size_t)M * D_IN_PAD * 2 <= WS_CQN &&
              WS_CQN + (size_t)M * 768 * 2 <= WS_CKVN && WS_CKVN + (size_t)M * 512 * 2 <= WS_KPE && WS_KPE + (size_t)M * 64 * 2 <= WS_Q && WS_ACT + (size_t)M * DFF * 2 <= WS_Q &&
              WS_Q + (size_t)M * 3072 * 2 <= WS_KN && WS_KN + (size_t)M * 2048 * 2 <= WS_V && WS_V + (size_t)M * 2048 * 2 <= WS_MIXRAW && WS_Y + (size_t)M * DM * 4 <= WS_MIXRAW &&
              WS_MIXRAW + (size_t)M * DM * 4 <= WS_ST && WS_ST + (size_t)2048 * 16384 * 4 <= WS_QG && WS_QG + (size_t)M * 1024 * 2 <= WS_DL && WS_DL + (size_t)2048 * 128 * 4 <= WS_END, "d_ws map");
constexpr int CW_BAR = 4096;

constexpr int RING_OFF = 0, RING_BYTES = 131072;
constexpr int LDSCTL_OFF = RING_BYTES, MISC_OFF = LDSCTL_OFF + 320;
constexpr int LDS_BYTES = 147456;

#define GAS __attribute__((address_space(1)))
#define LAS __attribute__((address_space(3)))
typedef unsigned short bf16;
typedef unsigned v4u __attribute__((ext_vector_type(4)));
typedef unsigned v2u __attribute__((ext_vector_type(2)));
typedef float f32x4 __attribute__((ext_vector_type(4)));
typedef GAS unsigned gu32;
#define RLX_AGENT __ATOMIC_RELAXED, __HIP_MEMORY_SCOPE_AGENT
#define LDS_WAIT() asm volatile("s_waitcnt lgkmcnt(0)" ::: "memory")
#define VM_WAIT() asm volatile("s_waitcnt vmcnt(0)" ::: "memory")
__device__ __forceinline__ float bf2f(unsigned b) { return __uint_as_float(b << 16); }
__device__ __forceinline__ float bflo(unsigned w) { return __uint_as_float(w << 16); }
__device__ __forceinline__ float bfhi(unsigned w) { return __uint_as_float(w & 0xffff0000u); }
__device__ __forceinline__ unsigned pk2(float lo, float hi) { return pg8::cvt_pk_bf16(lo, hi); }

#define XB_TMO      128
#define XB_XCNT(j)  (256  + 64 * (j))
#define XB_XSUB(j)  (1280 + 64 * (j))
#define XB_XGEN(j)  (2304 + 64 * (j))
#define XB_TOP      3328
#define XB_TOPGEN   3392
#define XCD_BAR_WORDS 3456
#define XB_SPIN_CAP (1u << 18)
__device__ __forceinline__ unsigned xb_ld(unsigned* p)              { return __hip_atomic_load(p, __ATOMIC_RELAXED, __HIP_MEMORY_SCOPE_AGENT); }
__device__ __forceinline__ unsigned xb_add(unsigned* p, unsigned v) { return __hip_atomic_fetch_add(p, v, __ATOMIC_RELAXED, __HIP_MEMORY_SCOPE_AGENT); }
__device__ __forceinline__ unsigned xb_xcc_id() { return (unsigned)__builtin_amdgcn_s_getreg((3 << 11) | 20) & 0xFu; }
#define XB_SPIN(cond, bar) do { unsigned _sp = 0; while (cond) { __builtin_amdgcn_s_sleep(1); \
    if ((++_sp & 255u) == 0u) { if (xb_ld(&(bar)[XB_TMO])) break; if (_sp > XB_SPIN_CAP) { atomicAdd(&(bar)[XB_TMO], 1u); break; } } } } while (0)
__device__ __forceinline__ int lane_id() { return (int)__builtin_amdgcn_mbcnt_hi(~0u, __builtin_amdgcn_mbcnt_lo(~0u, 0u)); }
struct XcdBarrier { unsigned* bar; unsigned x; volatile LAS unsigned* st; int wave; };
__device__ __forceinline__ XcdBarrier xcd_barrier_post(unsigned* bar, volatile LAS unsigned* st, int wave) {
    XcdBarrier b; b.bar = bar; b.x = xb_xcc_id(); b.st = st; b.wave = wave;
    if (wave == 0 && lane_id() == 0) (void)xb_add(&bar[XB_XCNT(b.x)], 1u);
    return b;
}
__device__ __forceinline__ void xcd_barrier_complete(unsigned* bar, unsigned x, unsigned& nloc, unsigned& nx) {
    const unsigned G = gridDim.x * gridDim.y * gridDim.z;
    unsigned sum, cnt, mine, sp = 0u;
    for (;;) {
        sum = 0u; cnt = 0u; mine = 0u;
#pragma unroll
        for (unsigned j = 0; j < 16; ++j) { const unsigned c = xb_ld(&bar[XB_XCNT(j)]); sum += c; cnt += (c > 0u) ? 1u : 0u; mine = (j == x) ? c : mine; }
        if (sum == G) break;
        __builtin_amdgcn_s_sleep(1);
        if ((++sp & 255u) == 0u) { if (xb_ld(&bar[XB_TMO])) break; if (sp > XB_SPIN_CAP) { atomicAdd(&bar[XB_TMO], 1u); break; } }
    }
    nloc = mine > 0u ? mine : 1u; nx = cnt > 0u ? cnt : 1u;
}
__device__ __forceinline__ void xcd_barrier(const XcdBarrier& b) {
    asm volatile("s_waitcnt vmcnt(0)" ::: "memory");
    __syncthreads();
    if (b.wave == 0 && lane_id() == 0) {
        unsigned* bar = b.bar;
        __builtin_amdgcn_s_waitcnt(0);
        unsigned nloc = b.st[0], nx = b.st[1];
        if (nloc == 0u) { xcd_barrier_complete(bar, b.x, nloc, nx); b.st[0] = nloc; b.st[1] = nx; }
        const unsigned old = xb_add(&bar[XB_XSUB(b.x)], 1u);
        const unsigned gen = old / nloc;
        if (old + 1u == (gen + 1u) * nloc) {
            __builtin_amdgcn_fence(__ATOMIC_RELEASE, "agent");
            asm volatile("s_waitcnt vmcnt(0)" ::: "memory");
            const unsigned og = xb_add(&bar[XB_TOP], 1u);
            const unsigned tg = og / nx;
            if (og + 1u == (tg + 1u) * nx) xb_add(&bar[XB_TOPGEN], 1u);
            else XB_SPIN(xb_ld(&bar[XB_TOPGEN]) == tg, bar);
            __builtin_amdgcn_fence(__ATOMIC_ACQUIRE, "agent");
            xb_add(&bar[XB_XGEN(b.x)], 1u);
            asm volatile("s_waitcnt vmcnt(0)" ::: "memory");
        } else {
            XB_SPIN(xb_ld(&bar[XB_XGEN(b.x)]) == gen, bar);
            __builtin_amdgcn_fence(__ATOMIC_ACQUIRE, "agent");
            asm volatile("s_waitcnt vmcnt(0)" ::: "memory");
        }
    }
    __syncthreads();
}

struct Frame {
    LAS unsigned char* lds;
    volatile LAS unsigned* MISC;
    gu32* ctl;
    int tid, lane, wave;
    int vcu, G;
    GAS unsigned char* ws;
};
struct Args { const float* in[20]; float* out; unsigned char* ws; int ph_lo, ph_hi, li, pad; };
typedef const __attribute__((address_space(4))) Args* CArgs;
__device__ __forceinline__ CArgs argp() { CArgs p = (CArgs)__builtin_amdgcn_kernarg_segment_ptr(); asm volatile("" : "+s"(p)); return p; }
#define INP(i) ((const GAS float*)(argp()->in[i]))
__device__ __forceinline__ float wave_sum(float v) {
#pragma unroll
    for (int o = 1; o < 64; o <<= 1) v += __shfl_xor(v, o);
    return v;
}

enum { MAP_ID = 0, MAP_UQ = 1, MAP_GATE = 2, MAP_UP = 3 };
__device__ __forceinline__ int map_row(int map, int n) {
    if (map == MAP_UQ) { const int h = n / 192, j = n % 192; if (j < 128) return h * 128 + j; const int i = j - 128; const int pos = (i < 32) ? 2 * i : 2 * (i - 32) + 1; return 2048 + h * 64 + pos; }
    if (map == MAP_GATE) return (n >> 7) * 256 + (n & 127);
    if (map == MAP_UP) return (n >> 7) * 256 + 128 + (n & 127);
    return n;
}
struct CvItem { const GAS float* W; GAS bf16* WT; const GAS float* gk; int K, N, map, k0, n0; };
__device__ __forceinline__ CvItem cv_item(Frame& F, int l, int it) {
    constexpr int I_IN = (DM / 64) * (D_IN / 32), I_UQ = (768 / 64) * (3072 / 32), I_UKV = (512 / 64) * (4096 / 32), I_OUT = (DM / 64) * (DM / 32), I_G = (DM / 64) * (DFF / 32);
    CvItem c; int r = it; c.gk = nullptr; c.map = MAP_ID;
    if (r < I_IN) { c.W = INP(4) + (size_t)l * DM * D_IN; c.WT = (GAS bf16*)(F.ws + WS_WIN); c.K = DM; c.N = D_IN; c.gk = INP(2) + (size_t)l * DM; }
    else if ((r -= I_IN) < I_UQ) { c.W = INP(7) + (size_t)l * 768 * 3072; c.WT = (GAS bf16*)(F.ws + WS_WUQ); c.K = 768; c.N = 3072; c.map = MAP_UQ; }
    else if ((r -= I_UQ) < I_UKV) { c.W = INP(8) + (size_t)l * 512 * 4096; c.WT = (GAS bf16*)(F.ws + WS_WUKV); c.K = 512; c.N = 4096; }
    else if ((r -= I_UKV) < I_OUT) { c.W = INP(14) + (size_t)l * DM * DM; c.WT = (GAS bf16*)(F.ws + WS_WOUT); c.K = DM; c.N = DM; }
    else if ((r -= I_OUT) < I_G) { c.W = INP(17) + (size_t)l * DM * DFF; c.WT = (GAS bf16*)(F.ws + WS_WGU); c.K = DM; c.N = DFF; c.map = MAP_GATE; c.gk = INP(15) + (size_t)l * DM; }
    else if ((r -= I_G) < I_G) { c.W = INP(18) + (size_t)l * DM * DFF; c.WT = (GAS bf16*)(F.ws + WS_WGU); c.K = DM; c.N = DFF; c.map = MAP_UP; c.gk = INP(15) + (size_t)l * DM; }
    else { r -= I_G; c.W = INP(19) + (size_t)l * DFF * DM; c.WT = (GAS bf16*)(F.ws + WS_WD); c.K = DFF; c.N = DM; }
    const int nblk = c.N / 32; c.k0 = 64 * ((r / (4 * nblk)) * 4 + (r & 3)); c.n0 = 32 * ((r >> 2) % nblk);
    return c;
}
__device__ __forceinline__ void cv_load(const CvItem& c, int lane, f32x4 (&v)[8], f32x4& ga, f32x4& gb) {
    const int kr = lane >> 3, c4 = lane & 7;
#pragma unroll
    for (int i = 0; i < 8; ++i) v[i] = __builtin_nontemporal_load((const GAS f32x4*)(c.W + (size_t)(c.k0 + 8 * i + kr) * c.N + c.n0 + 4 * c4));
    ga = (f32x4){1.f, 1.f, 1.f, 1.f}; gb = ga; if (c.gk) { ga = *(const GAS f32x4*)(c.gk + c.k0 + 8 * (lane & 7)); gb = *(const GAS f32x4*)(c.gk + c.k0 + 8 * (lane & 7) + 4); }
}
__device__ __forceinline__ void cv_store(const CvItem& c, int lane, LAS float* scr, const f32x4 (&v)[8], const f32x4 ga, const f32x4 gb) {
    { const int kr = lane >> 3, c4 = lane & 7;
#pragma unroll
      for (int i = 0; i < 8; ++i) { LAS float* d = scr + (8 * i + kr) * 33 + 4 * c4; d[0] = v[i].x; d[1] = v[i].y; d[2] = v[i].z; d[3] = v[i].w; } }
    LDS_WAIT(); asm volatile("" ::: "memory");
    const int cc = lane & 7;
#pragma unroll
    for (int j = 0; j < 4; ++j) { const int n = (lane >> 3) + 8 * j; const LAS float* s = scr + (8 * cc) * 33 + n;
        v4u o; o.x = pk2(s[0 * 33] * ga.x, s[1 * 33] * ga.y); o.y = pk2(s[2 * 33] * ga.z, s[3 * 33] * ga.w); o.z = pk2(s[4 * 33] * gb.x, s[5 * 33] * gb.y); o.w = pk2(s[6 * 33] * gb.z, s[7 * 33] * gb.w);
        *(GAS v4u*)(c.WT + (size_t)map_row(c.map, c.n0 + n) * c.K + c.k0 + 8 * cc) = o; }
    LDS_WAIT(); asm volatile("" ::: "memory");
}
__device__ __forceinline__ void convert_weights(Frame& F, int l) {
    LAS float* scr = (LAS float*)(F.lds + RING_OFF + F.wave * 16384);
    const int gw = F.vcu * NWAVES + F.wave, NGW = F.G * NWAVES;
    constexpr int NITEMS = (DM / 64) * (D_IN / 32) + (768 / 64) * (3072 / 32) + (512 / 64) * (4096 / 32) + (DM / 64) * (DM / 32) + 2 * (DM / 64) * (DFF / 32) + (DFF / 64) * (DM / 32);
    int it = gw;
    if (it < NITEMS) {
        CvItem cur = cv_item(F, l, it); f32x4 v[8], ga, gb; cv_load(cur, F.lane, v, ga, gb);
        for (;;) {
            const int nx = it + NGW; const bool has = nx < NITEMS;
            CvItem nxt = cur; f32x4 w[8], ha = ga, hb = gb;
            if (has) { nxt = cv_item(F, l, nx); cv_load(nxt, F.lane, w, ha, hb); }
            cv_store(cur, F.lane, scr, v, ga, gb);
            if (!has) break;
            cur = nxt; ga = ha; gb = hb; it = nx;
#pragma unroll
            for (int i = 0; i < 8; ++i) v[i] = w[i];
        }
    }
    { GAS v4u* z = (GAS v4u*)((GAS bf16*)(F.ws + WS_WIN) + (size_t)D_IN * DM); const int nz = (D_IN_PAD - D_IN) * DM * 2 / 16;
      for (int i = F.vcu * 512 + F.tid; i < nz; i += F.G * 512) z[i] = (v4u){0u, 0u, 0u, 0u}; }
}
__device__ __forceinline__ void make_tables(Frame& F) {
    const GAS int* pos = (const GAS int*)INP(1); GAS float* rope = (GAS float*)(F.ws + WS_ROPE); GAS float* LB = (GAS float*)(F.ws + WS_LB); const GAS float* lbraw = INP(10);
    for (int idx = F.vcu * 512 + F.tid; idx < M * 32; idx += F.G * 512) {
        const int m = idx >> 5, i = idx & 31;
        const float e = (-18.420680743952367f * (float)i) / 64.0f;
        const float inv_freq = (float)exp((double)e);
        const float ang = (float)pos[m] * inv_freq;
        const double rev = (double)ang * 0.15915494309189535;
        const float fr = (float)(rev - rint(rev));
        rope[(size_t)idx * 2] = __builtin_amdgcn_cosf(fr); rope[(size_t)idx * 2 + 1] = __builtin_amdgcn_sinf(fr);
    }
    for (int c = F.vcu * 512 + F.tid; c < 1024; c += F.G * 512) { const float a0 = lbraw[c], a1 = lbraw[1024 + c]; LB[c] = 0.f; LB[1024 + c] = 1.0f / (1.0f + expf(a0 - a1)); }
}
__device__ __forceinline__ void phase_n1(Frame& F, const GAS float* x) {
    const int gw = F.vcu * NWAVES + F.wave, NGW = F.G * NWAVES; GAS bf16* X = (GAS bf16*)(F.ws + WS_XN); GAS float* RS1 = (GAS float*)(F.ws + WS_RS1);
    for (int m = gw; m < M; m += NGW) {
        const GAS f32x4* xr = (const GAS f32x4*)(x + (size_t)m * DM) + F.lane; GAS v2u* o8 = (GAS v2u*)(X + (size_t)m * DM) + F.lane;
        f32x4 v[16]; float s = 0.f;
#pragma unroll
        for (int j = 0; j < 16; ++j) { v[j] = __builtin_nontemporal_load(xr + 64 * j); s += (v[j].x * v[j].x + v[j].y * v[j].y) + (v[j].z * v[j].z + v[j].w * v[j].w); }
        s = wave_sum(s);
#pragma unroll
        for (int j = 0; j < 16; ++j) { v2u w; w.x = pk2(v[j].x, v[j].y); w.y = pk2(v[j].z, v[j].w); o8[64 * j] = w; }
        if (F.lane == 0) RS1[m] = 1.0f / sqrtf(s * (1.f / DM) + EPS);
    }
}
__device__ __forceinline__ void phase_resid(Frame& F, const GAS float* gpost, GAS float* rs_out, GAS float* outf) {
    const int gw = F.vcu * NWAVES + F.wave, NGW = F.G * NWAVES; GAS bf16* X = (GAS bf16*)(F.ws + WS_XN); const GAS bf16* Y = (const GAS bf16*)(F.ws + WS_Y);
    for (int m = gw; m < M; m += NGW) {
        const GAS v2u* yr = (const GAS v2u*)(Y + (size_t)m * DM) + F.lane; GAS v2u* xr = (GAS v2u*)(X + (size_t)m * DM) + F.lane;
        const GAS f32x4* gp = (const GAS f32x4*)gpost + F.lane;
        f32x4 v[16]; float s = 0.f;
#pragma unroll
        for (int j = 0; j < 16; ++j) { const v2u w = yr[64 * j]; v[j] = (f32x4){bflo(w.x), bfhi(w.x), bflo(w.y), bfhi(w.y)}; s += (v[j].x * v[j].x + v[j].y * v[j].y) + (v[j].z * v[j].z + v[j].w * v[j].w); }
        const float rstd = 1.0f / sqrtf(wave_sum(s) * (1.f / DM) + EPS);
        float s2 = 0.f;
#pragma unroll
        for (int j = 0; j < 16; ++j) { const v2u w = xr[64 * j]; const f32x4 xx = (f32x4){bflo(w.x), bfhi(w.x), bflo(w.y), bfhi(w.y)}, gg = gp[64 * j]; v[j] = xx + v[j] * rstd * gg;
            s2 += (v[j].x * v[j].x + v[j].y * v[j].y) + (v[j].z * v[j].z + v[j].w * v[j].w); }
        if (outf) { GAS f32x4* xo = (GAS f32x4*)(outf + (size_t)m * DM) + F.lane;
#pragma unroll
            for (int j = 0; j < 16; ++j) xo[64 * j] = v[j]; }
        else {
#pragma unroll
            for (int j = 0; j < 16; ++j) { v2u w; w.x = pk2(v[j].x, v[j].y); w.y = pk2(v[j].z, v[j].w); xr[64 * j] = w; } }
        if (rs_out) { s2 = wave_sum(s2); if (F.lane == 0) rs_out[m] = 1.0f / sqrtf(s2 * (1.f / DM) + EPS); }
    }
}
__device__ __forceinline__ void phase_n2(Frame& F, int l) {
    const int gw = F.vcu * NWAVES + F.wave, NGW = F.G * NWAVES;
    const GAS bf16* H = (const GAS bf16*)(F.ws + WS_H); GAS bf16* CQN = (GAS bf16*)(F.ws + WS_CQN); GAS bf16* CKVN = (GAS bf16*)(F.ws + WS_CKVN); GAS bf16* KPE = (GAS bf16*)(F.ws + WS_KPE);
    const GAS float* qn = INP(5) + (size_t)l * 768; const GAS float* kvn = INP(6) + (size_t)l * 512; const GAS float* rope = (const GAS float*)(F.ws + WS_ROPE);
    for (int m = gw; m < M; m += NGW) {
        const GAS bf16* hr = H + (size_t)m * D_IN_PAD;
        { float x[12]; float s = 0.f;
#pragma unroll
          for (int j = 0; j < 3; ++j) { const v2u w = *(const GAS v2u*)(hr + OFF_CQ + 256 * j + 4 * F.lane); x[4 * j] = bflo(w.x); x[4 * j + 1] = bfhi(w.x); x[4 * j + 2] = bflo(w.y); x[4 * j + 3] = bfhi(w.y); }
#pragma unroll
          for (int j = 0; j < 12; ++j) s += x[j] * x[j];
          const float rstd = 1.0f / sqrtf(wave_sum(s) * (1.f / 768.f) + EPS);
#pragma unroll
          for (int j = 0; j < 3; ++j) { const f32x4 g = *(const GAS f32x4*)(qn + 256 * j + 4 * F.lane); v2u w; w.x = pk2(x[4 * j] * rstd * g.x, x[4 * j + 1] * rstd * g.y); w.y = pk2(x[4 * j + 2] * rstd * g.z, x[4 * j + 3] * rstd * g.w);
              *(GAS v2u*)(CQN + (size_t)m * 768 + 256 * j + 4 * F.lane) = w; } }
        { float x[8]; float s = 0.f;
#pragma unroll
          for (int j = 0; j < 2; ++j) { const v2u w = *(const GAS v2u*)(hr + OFF_CKV + 256 * j + 4 * F.lane); x[4 * j] = bflo(w.x); x[4 * j + 1] = bfhi(w.x); x[4 * j + 2] = bflo(w.y); x[4 * j + 3] = bfhi(w.y); }
#pragma unroll
          for (int j = 0; j < 8; ++j) s += x[j] * x[j];
          const float rstd = 1.0f / sqrtf(wave_sum(s) * (1.f / 512.f) + EPS);
#pragma unroll
          for (int j = 0; j < 2; ++j) { const f32x4 g = *(const GAS f32x4*)(kvn + 256 * j + 4 * F.lane); v2u w; w.x = pk2(x[4 * j] * rstd * g.x, x[4 * j + 1] * rstd * g.y); w.y = pk2(x[4 * j + 2] * rstd * g.z, x[4 * j + 3] * rstd * g.w);
              *(GAS v2u*)(CKVN + (size_t)m * 512 + 256 * j + 4 * F.lane) = w; } }
        if (F.lane < 32) { const int i = F.lane; const float t1 = bf2f(hr[OFF_KR + i]), t2 = bf2f(hr[OFF_KR + 32 + i]); const float c = rope[(size_t)m * 64 + 2 * i], sn = rope[(size_t)m * 64 + 2 * i + 1];
            *(GAS unsigned*)(KPE + (size_t)m * 64 + 2 * i) = pk2(t1 * c - t2 * sn, t1 * sn + t2 * c); }
    }
}

namespace att {
using bf16x8 = __attribute__((ext_vector_type(8))) short;
using s16x4  = __attribute__((ext_vector_type(4))) short;
using f32x16 = __attribute__((ext_vector_type(16))) float;
using u32x4  = __attribute__((ext_vector_type(4))) unsigned;
constexpr int SHM_V = 64 * 128 * 2, SHM_K = 64 * 272, SHM_KP = 64 * 144, QP_WAVE = 32 * 144;
constexpr int OFF_V = 0, OFF_K = 2 * SHM_V, OFF_KP = OFF_K + 2 * SHM_K, OFF_WS = OFF_KP + 2 * SHM_KP, OFF_QP = OFF_WS + 8 * 64 * 4, OFF_BIAS = OFF_QP + 8 * QP_WAVE, ATT_LDS = OFF_BIAS + 768 * 4;
constexpr float THR2 = 8.0f * 1.4426950408889634f;
#define KSWZ(row, colB) ((row) * 272 + (colB))
#define KPSWZ(row, colB) ((row) * 144 + (colB))
#define SBAR() __builtin_amdgcn_sched_barrier(0)
__device__ __forceinline__ int crow(int r, int hi) { return (r & 3) + 8 * (r >> 2) + 4 * hi; }
__device__ __forceinline__ unsigned cvtpk(float lo, float hi) { unsigned r; asm volatile("v_cvt_pk_bf16_f32 %0, %1, %2" : "=v"(r) : "v"(lo), "v"(hi)); return r; }
template <bool CA>
__device__ __forceinline__ void partialSM(f32x16& p0, f32x16& p1, float& m_reg, float& mn, float& alpha, bool masked, const float* ext, int xb) {
  if (masked) { for (int r = 0; r < 16; ++r) { p0[r] = -3e38f; p1[r] = -3e38f; } }
  else if constexpr (CA) {
    constexpr float C = 0.08838834764831845f * 1.4426950408889634f;
    for (int r = 0; r < 16; ++r) { const int ko = (r & 3) + 8 * (r >> 2); p0[r] = fmaf(p0[r], C, ext[xb - ko]); p1[r] = fmaf(p1[r], C, ext[xb - 32 - ko]); }
  }
  float pmax = p0[0]; for (int r = 1; r < 16; ++r) pmax = fmaxf(pmax, p0[r]); for (int r = 0; r < 16; ++r) pmax = fmaxf(pmax, p1[r]);
  { auto rr = __builtin_amdgcn_permlane32_swap(__float_as_uint(pmax), __float_as_uint(pmax), false, false);
    pmax = fmaxf(__uint_as_float(rr[0]), __uint_as_float(rr[1])); }
  if (__builtin_expect(__all(pmax - m_reg <= THR2), 1)) { mn = m_reg; alpha = 1.f; }
  else { mn = fmaxf(m_reg, pmax); alpha = __builtin_amdgcn_exp2f(m_reg - mn); m_reg = mn; }
  for (int r = 0; r < 16; ++r) p0[r] = p0[r] - mn; for (int r = 0; r < 16; ++r) p1[r] = p1[r] - mn;
  for (int r = 0; r < 16; ++r) p0[r] = __builtin_amdgcn_exp2f(p0[r]);
}
__device__ __forceinline__ void finishSM(f32x16& p0, f32x16& p1, float alpha, float& l_reg, bf16x8& pa0, bf16x8& pa1, bf16x8& pa2, bf16x8& pa3) {
  for (int r = 0; r < 16; ++r) p1[r] = __builtin_amdgcn_exp2f(p1[r]);
  float ps = 0; for (int r = 0; r < 16; ++r) ps += p0[r]; for (int r = 0; r < 16; ++r) ps += p1[r];
  { auto rr = __builtin_amdgcn_permlane32_swap(__float_as_uint(ps), __float_as_uint(ps), false, false);
    ps = __uint_as_float(rr[0]) + __uint_as_float(rr[1]); }
  l_reg = l_reg * alpha + ps;
#define PK4(P, BASE, OUT) do { unsigned a0 = cvtpk(P[BASE + 0], P[BASE + 1]), a1 = cvtpk(P[BASE + 2], P[BASE + 3]);   \
    unsigned b0 = cvtpk(P[BASE + 4], P[BASE + 5]), b1 = cvtpk(P[BASE + 6], P[BASE + 7]);                              \
    auto r0 = __builtin_amdgcn_permlane32_swap(a0, b0, false, false); auto r1 = __builtin_amdgcn_permlane32_swap(a1, b1, false, false); \
    u32x4 w = {r0[0], r1[0], r0[1], r1[1]}; OUT = *reinterpret_cast<bf16x8*>(&w); } while (0)
  PK4(p0, 0, pa0); PK4(p0, 8, pa1); PK4(p1, 0, pa2); PK4(p1, 8, pa3);
#undef PK4
}
template <int ND0>
__device__ __forceinline__ void qkt(f32x16& p0, f32x16& p1, const char* Ks, const char* Kps, const bf16x8* qr, const char* Qps, int r32, int hi) {
  p0 = f32x16{}; p1 = f32x16{};
#pragma unroll
  for (int d0 = 0; d0 < 8; ++d0) { const int cb = (d0 * 16 + hi * 8) * 2;
    bf16x8 b0 = *reinterpret_cast<const bf16x8*>(Ks + KSWZ(r32, cb));
    bf16x8 b1 = *reinterpret_cast<const bf16x8*>(Ks + KSWZ(32 + r32, cb));
    p0 = __builtin_amdgcn_mfma_f32_32x32x16_bf16(b0, qr[d0], p0, 0, 0, 0);
    p1 = __builtin_amdgcn_mfma_f32_32x32x16_bf16(b1, qr[d0], p1, 0, 0, 0); }
  if constexpr (ND0 > 8) {
#pragma unroll
    for (int d0 = 8; d0 < ND0; ++d0) { const int cb = ((d0 - 8) * 16 + hi * 8) * 2;
      bf16x8 b0 = *reinterpret_cast<const bf16x8*>(Kps + KPSWZ(r32, cb));
      bf16x8 b1 = *reinterpret_cast<const bf16x8*>(Kps + KPSWZ(32 + r32, cb));
      bf16x8 qv = *reinterpret_cast<const bf16x8*>(Qps + KPSWZ(r32, cb));
      p0 = __builtin_amdgcn_mfma_f32_32x32x16_bf16(b0, qv, p0, 0, 0, 0);
      p1 = __builtin_amdgcn_mfma_f32_32x32x16_bf16(b1, qv, p1, 0, 0, 0); }
  }
}
__device__ __forceinline__ int v_st(int k, int c) { const int kk = (k & ~0xC) | ((k & 4) << 1) | ((k & 8) >> 1); return ((kk >> 3) * 4 + (c >> 5)) * 512 + ((kk & 7) * 32 + (c & 31)) * 2; }
__device__ __forceinline__ int v_rd_base(int lane) { return ((lane & 3) << 3) | (((lane >> 2) & 3) << 6) | (((lane >> 4) & 1) << 5) | (((lane >> 5) & 1) << 8); }
constexpr int v_rd_off(int d0, int ks, int half) { return d0 * 512 + ks * 4096 + half * 2048; }
template <int OFF> __device__ __forceinline__ s16x4 tr_read(int vb) {
  s16x4 r; asm volatile("ds_read_b64_tr_b16 %0, %1 offset:%2" : "=&v"(r) : "v"(vb), "i"(OFF) : "memory"); return r;
}
template <int D0> __device__ __forceinline__ void pv_one(f32x16& od, int vb, bf16x8 pa0, bf16x8 pa1, bf16x8 pa2, bf16x8 pa3) {
  const s16x4 l0 = tr_read<v_rd_off(D0, 0, 0)>(vb), h0 = tr_read<v_rd_off(D0, 0, 1)>(vb), l1 = tr_read<v_rd_off(D0, 1, 0)>(vb), h1 = tr_read<v_rd_off(D0, 1, 1)>(vb);
  const s16x4 l2 = tr_read<v_rd_off(D0, 2, 0)>(vb), h2 = tr_read<v_rd_off(D0, 2, 1)>(vb), l3 = tr_read<v_rd_off(D0, 3, 0)>(vb), h3 = tr_read<v_rd_off(D0, 3, 1)>(vb);
  asm volatile("s_waitcnt lgkmcnt(0)" ::: "memory"); SBAR();
#define PK(L, H) (bf16x8){L[0], L[1], L[2], L[3], H[0], H[1], H[2], H[3]}
  od = __builtin_amdgcn_mfma_f32_32x32x16_bf16(pa0, PK(l0, h0), od, 0, 0, 0);
  od = __builtin_amdgcn_mfma_f32_32x32x16_bf16(pa1, PK(l1, h1), od, 0, 0, 0);
  od = __builtin_amdgcn_mfma_f32_32x32x16_bf16(pa2, PK(l2, h2), od, 0, 0, 0);
  od = __builtin_amdgcn_mfma_f32_32x32x16_bf16(pa3, PK(l3, h3), od, 0, 0, 0);
#undef PK
}
__device__ __forceinline__ void pv_d0(f32x16* o, int vb, bf16x8 pa0, bf16x8 pa1, bf16x8 pa2, bf16x8 pa3) {
  pv_one<0>(o[0], vb, pa0, pa1, pa2, pa3); pv_one<1>(o[1], vb, pa0, pa1, pa2, pa3); pv_one<2>(o[2], vb, pa0, pa1, pa2, pa3); pv_one<3>(o[3], vb, pa0, pa1, pa2, pa3);
}

#define AGAS __attribute__((address_space(1)))
template <bool CA>
__device__ __forceinline__ void attn_unit(const AGAS bf16* __restrict__ Qb, const AGAS bf16* __restrict__ Kn, const AGAS bf16* __restrict__ Kp, const AGAS bf16* __restrict__ Vh,
                                          AGAS bf16* __restrict__ Ob, int ldo, int qb, const AGAS float* __restrict__ bias_h, char* lds, int tid_in) {
  constexpr int LDQ = CA ? 8704 : 3072, LDK = CA ? 8704 : 2048, LDKP = 64, ND0 = CA ? 8 : 12, WIN = CA ? 8 : 100000;
  int tid = tid_in; asm volatile("" : "+v"(tid));
  const int wid = __builtin_amdgcn_readfirstlane(tid >> 6), lane = tid & 63, r32 = lane & 31, hi = lane >> 5;
  char* V_lds = lds + OFF_V; char* K_lds = lds + OFF_K; char* Kp_lds = lds + OFF_KP;
  float* ws = (float*)(lds + OFF_WS) + wid * 64; float* li_l = ws; float* al_l = ws + 32;
  float* ext = (float*)(lds + OFF_BIAS);
  float m_reg = -1e30f, l_reg = 0; f32x16 o[4] = {}; bf16x8 qr[8];
  char* Qp_lds = lds + OFF_QP + wid * QP_WAVE;
  const AGAS bf16* Qw = Qb + (long)(wid * 32 + r32) * LDQ + hi * 8;
#pragma unroll
  for (int d0 = 0; d0 < 8; ++d0) qr[d0] = *(const AGAS bf16x8*)(Qw + d0 * 16);
  const int sr = tid >> 4, sc = (tid & 15) * 8, vst0 = v_st(sr, sc), vst1 = v_st(32 + sr, sc);
  const int pr = tid >> 3, pc = (tid & 7) * 8;
  const int vb0 = (int)(uintptr_t)V_lds + v_rd_base(lane);
  const int cw = 4 * qb + (wid >> 1);
  const int tile0 = CA ? (4 * qb - 8 > 0 ? 4 * qb - 8 : 0) : 0, NT = 4 * qb + 4 - tile0;
  const int xq = 256 * qb + 32 * wid + r32 + 64 - 4 * hi;
  bf16x8 s_vs0, s_vs1, s_ks0, s_ks1, s_kp;
#define SLOAD(jt) do { const long k0_ = (long)(tile0 + (jt)) * 64; s_vs0 = *(const AGAS bf16x8*)(&Vh[(k0_ + sr) * LDK + sc]); s_vs1 = *(const AGAS bf16x8*)(&Vh[(k0_ + 32 + sr) * LDK + sc]); \
    s_ks0 = *(const AGAS bf16x8*)(&Kn[(k0_ + sr) * LDK + sc]); s_ks1 = *(const AGAS bf16x8*)(&Kn[(k0_ + 32 + sr) * LDK + sc]); \
    if constexpr (!CA) s_kp = *(const AGAS bf16x8*)(&Kp[(k0_ + pr) * LDKP + pc]); } while (0)
#define SWRITE(b) do { *(bf16x8*)(V_lds + (b) * SHM_V + vst0) = s_vs0; *(bf16x8*)(V_lds + (b) * SHM_V + vst1) = s_vs1; \
    *(bf16x8*)(K_lds + (b) * SHM_K + KSWZ(sr, sc * 2)) = s_ks0; *(bf16x8*)(K_lds + (b) * SHM_K + KSWZ(32 + sr, sc * 2)) = s_ks1; \
    if constexpr (!CA) *(bf16x8*)(Kp_lds + (b) * SHM_KP + KPSWZ(pr, pc * 2)) = s_kp; } while (0)
#define RESC(a) do { if (__any((a) < 1.f)) { if (hi == 0) al_l[r32] = (a); asm volatile("s_waitcnt lgkmcnt(0)" ::: "memory"); \
    for (int d = 0; d < 4; ++d) for (int r = 0; r < 16; ++r) o[d][r] *= al_l[crow(r, hi)]; } } while (0)
#define MASKED(jt) ((tile0 + (jt)) > cw || (tile0 + (jt)) < cw - WIN)
#define XB(jt) (xq - 64 * (tile0 + (jt)))
  f32x16 pA0, pA1, pB0, pB1; float mnA, mnB, alA, alB; bf16x8 pa0, pa1, pa2, pa3;
  __syncthreads();
  if constexpr (!CA) {
#pragma unroll
    for (int d = 0; d < 4; ++d) *(bf16x8*)(Qp_lds + KPSWZ(r32, (d * 16 + hi * 8) * 2)) = *(const AGAS bf16x8*)(Qw + 128 + d * 16);
  } else {
    for (int x = tid; x < 768; x += 512) { int d = x - 64; d = d < -256 ? -256 : (d > 256 ? 256 : d); ext[x] = bias_h[d + 256] * 1.4426950408889634f; }
  }
  SLOAD(0); asm volatile("s_waitcnt vmcnt(0)" ::: "memory"); SWRITE(0); __syncthreads();
  if (!MASKED(0)) qkt<ND0>(pA0, pA1, K_lds, Kp_lds, qr, Qp_lds, r32, hi);
  partialSM<CA>(pA0, pA1, m_reg, mnA, alA, MASKED(0), ext, XB(0));
  SLOAD(1);
  asm volatile("s_waitcnt vmcnt(0)" ::: "memory"); SWRITE(1); __syncthreads();
  for (int j = 1; j + 1 < NT; j += 2) {
    SBAR(); if (!MASKED(j)) qkt<ND0>(pB0, pB1, K_lds + SHM_K, Kp_lds + SHM_KP, qr, Qp_lds, r32, hi);
    finishSM(pA0, pA1, alA, l_reg, pa0, pa1, pa2, pa3); SBAR();
    SLOAD(j + 1); SBAR();
    if (!MASKED(j - 1)) pv_d0(o, vb0, pa0, pa1, pa2, pa3); partialSM<CA>(pB0, pB1, m_reg, mnB, alB, MASKED(j), ext, XB(j));
    __syncthreads(); asm volatile("s_waitcnt vmcnt(0)" ::: "memory"); SWRITE(0);
    RESC(alB); __syncthreads();
    SBAR(); if (!MASKED(j + 1)) qkt<ND0>(pA0, pA1, K_lds, Kp_lds, qr, Qp_lds, r32, hi);
    finishSM(pB0, pB1, alB, l_reg, pa0, pa1, pa2, pa3); SBAR();
    SLOAD(j + 2); SBAR();
    if (!MASKED(j)) pv_d0(o, vb0 + SHM_V, pa0, pa1, pa2, pa3); partialSM<CA>(pA0, pA1, m_reg, mnA, alA, MASKED(j + 1), ext, XB(j + 1));
    __syncthreads(); asm volatile("s_waitcnt vmcnt(0)" ::: "memory"); SWRITE(1);
    RESC(alA); __syncthreads();
  }
  SBAR(); if (!MASKED(NT - 1)) qkt<ND0>(pB0, pB1, K_lds + SHM_K, Kp_lds + SHM_KP, qr, Qp_lds, r32, hi);
  finishSM(pA0, pA1, alA, l_reg, pa0, pa1, pa2, pa3); SBAR();
  if (!MASKED(NT - 2)) pv_d0(o, vb0, pa0, pa1, pa2, pa3);
  partialSM<CA>(pB0, pB1, m_reg, mnB, alB, MASKED(NT - 1), ext, XB(NT - 1));
  __syncthreads(); RESC(alB);
  finishSM(pB0, pB1, alB, l_reg, pa0, pa1, pa2, pa3); SBAR();
  if (!MASKED(NT - 1)) pv_d0(o, vb0 + SHM_V, pa0, pa1, pa2, pa3);
  if (hi == 0) li_l[r32] = l_reg; asm volatile("s_waitcnt lgkmcnt(0)" ::: "memory");
  int lane2 = lane; asm volatile("" : "+v"(lane2));
  const int r32e = lane2 & 31, hie = lane2 >> 5;
  AGAS bf16* Ow = Ob + (long)(wid * 32) * ldo;
#pragma unroll
  for (int hh = 0; hh < 2; ++hh) {
#pragma unroll
    for (int r = 0; r < 16; ++r) { const int orow = crow(r, hie); const float rl = __builtin_amdgcn_rcpf(li_l[orow]);
#pragma unroll
      for (int dd = 0; dd < 2; ++dd) *(bf16*)(Qp_lds + orow * 128 + (dd * 32 + r32e) * 2) = (bf16)(cvtpk(o[2 * hh + dd][r] * rl, 0.f) & 0xffffu); }
    asm volatile("s_waitcnt lgkmcnt(0)" ::: "memory");
#pragma unroll
    for (int i = 0; i < 4; ++i) { const int v = lane2 + 64 * i, row = v >> 3, c16 = v & 7; *(AGAS u32x4*)(Ow + (long)row * ldo + 64 * hh + c16 * 8) = *(const u32x4*)(Qp_lds + row * 128 + c16 * 16); }
    asm volatile("s_waitcnt lgkmcnt(0)" ::: "memory");
  }
#undef SLOAD
#undef SWRITE
#undef RESC
#undef MASKED
#undef XB
}
}

namespace hg {
typedef short bf16x8 __attribute__((ext_vector_type(8)));
typedef float f32x4 __attribute__((ext_vector_type(4)));
constexpr int B_OFF = 0, KK_OFF = 32768, VT_OFF = 65536, QD_OFF = 83968, KT_OFF = 101376, P_OFF = 119808, TOT_OFF = 129024;
__device__ __forceinline__ unsigned short f2bf16(float x) { return (unsigned short)(pg8::cvt_pk_bf16(x, 0.f) & 0xffffu); }

__device__ __forceinline__ void hgrn_a_unit(Frame& F, int l, int u) {
    int t = F.tid; asm volatile("" : "+v"(t));
    const int c = u & 127, bh = u >> 7, b = bh >> 3, h = bh & 7;
    const int s = t >> 7, k = t & 127, lane = t & 63, wave = F.wave, lr = lane & 15, lq = lane >> 4;
    const size_t m0 = (size_t)b * SEQ + 64 * c;
    const GAS bf16* Hb = (const GAS bf16*)(F.ws + WS_H) + m0 * D_IN_PAD + h * 128 + k;
    LAS float* Bs = (LAS float*)(F.lds + B_OFF); LAS float* KK = (LAS float*)(F.lds + KK_OFF); LAS float* TOT = (LAS float*)(F.lds + TOT_OFF);
    LAS bf16* VT = (LAS bf16*)(F.lds + VT_OFF); LAS bf16* QD = (LAS bf16*)(F.lds + QD_OFF); LAS bf16* KT = (LAS bf16*)(F.lds + KT_OFF); LAS bf16* P = (LAS bf16*)(F.lds + P_OFF);
    const float lb = ((const GAS float*)(F.ws + WS_LB))[l * 1024 + h * 128 + k];
    GAS float* MR = (GAS float*)(F.ws + WS_MIXRAW); GAS bf16* ST = (GAS bf16*)(F.ws + WS_ST) + (size_t)u * 16384; GAS bf16* QG = (GAS bf16*)(F.ws + WS_QG); GAS float* DL = (GAS float*)(F.ws + WS_DL) + (size_t)u * 128;
    __syncthreads();
    float breg[16]; unsigned qraw[16]; float run = 0.f;
#pragma unroll
    for (int i = 0; i < 16; ++i) { const int tok = 16 * s + i; const GAS bf16* hr = Hb + (size_t)tok * D_IN_PAD;
        const float fp = bf2f(hr[OFF_HF]); qraw[i] = hr[OFF_HQ]; VT[k * 72 + tok] = hr[OFF_HI];
        const float f = lb + (1.0f - lb) / (1.0f + __expf(-fp));
        KK[tok * 128 + k] = (1.0f - lb) / (1.0f + __expf(fp));
        run += __logf(fmaxf(f, 1e-30f)); breg[i] = run; }
    TOT[s * 128 + k] = run;
    __syncthreads();
    const float t0 = TOT[k], t1 = TOT[128 + k], t2 = TOT[256 + k], t3 = TOT[384 + k];
    const float off = (s > 0 ? t0 : 0.f) + (s > 1 ? t1 : 0.f) + (s > 2 ? t2 : 0.f);
#pragma unroll
    for (int i = 0; i < 16; ++i) { const int tok = 16 * s + i; const float qv = bf2f(qraw[i]); const float qh = qv / (1.0f + __expf(-qv));
        Bs[tok * 128 + k] = breg[i] + off; QD[tok * 136 + k] = f2bf16(qh * __expf(breg[i]));
        { const float qg = qh * __expf(breg[i] + off), other = __shfl_xor(qg, 1); if ((k & 1) == 0) *(GAS unsigned*)(QG + (m0 + tok) * 1024 + h * 128 + k) = pk2(qg, other); } }
    const float b63 = (t0 + t1) + (t2 + t3);
    if (s == 3) DL[k] = __expf(b63);
    __syncthreads();
#pragma unroll 1
    for (int a = 0; a < 4; ++a) {
        const float ca = (a > 0 ? t0 : 0.f) + (a > 1 ? t1 : 0.f) + (a > 2 ? t2 : 0.f);
        for (int r = 0; r < 4 * (a + 1); ++r) { const int j = s + 4 * r; KT[j * 136 + k] = f2bf16(KK[j * 128 + k] * __expf(fminf(ca - Bs[j * 128 + k], 80.f))); }
        __syncthreads();
        if (wave < 4) {
            f32x4 acc = (f32x4){0.f, 0.f, 0.f, 0.f};
            if (wave <= a) {
#pragma unroll
                for (int ks = 0; ks < 4; ++ks) { const bf16x8 af = *(const LAS bf16x8*)(QD + (16 * a + lr) * 136 + 32 * ks + 8 * lq), bfr = *(const LAS bf16x8*)(KT + (16 * wave + lr) * 136 + 32 * ks + 8 * lq);
                    acc = __builtin_amdgcn_mfma_f32_16x16x32_bf16(af, bfr, acc, 0, 0, 0); }
            }
#pragma unroll
            for (int reg = 0; reg < 4; ++reg) { const int i = 4 * lq + reg, j = lr; float pv = acc[reg]; if (wave == a && j > i) pv = 0.f; P[(16 * a + i) * 72 + 16 * wave + j] = f2bf16(pv); }
        }
        __syncthreads();
    }
    LAS bf16* KET = KT;
#pragma unroll 4
    for (int r = 0; r < 16; ++r) { const int j = s + 4 * r; KET[k * 72 + j] = f2bf16(KK[j * 128 + k] * __expf(b63 - Bs[j * 128 + k])); }
    __syncthreads();
    {
        bf16x8 vb[2];
#pragma unroll
        for (int ks = 0; ks < 2; ++ks) vb[ks] = *(const LAS bf16x8*)(VT + (16 * wave + lr) * 72 + 32 * ks + 8 * lq);
#pragma unroll
        for (int rb = 0; rb < 4; ++rb) { f32x4 acc = (f32x4){0.f, 0.f, 0.f, 0.f};
#pragma unroll
            for (int ks = 0; ks < 2; ++ks) { const bf16x8 af = *(const LAS bf16x8*)(P + (16 * rb + lr) * 72 + 32 * ks + 8 * lq); acc = __builtin_amdgcn_mfma_f32_16x16x32_bf16(af, vb[ks], acc, 0, 0, 0); }
#pragma unroll
            for (int reg = 0; reg < 4; ++reg) MR[(m0 + 16 * rb + 4 * lq + reg) * DM + 2048 + h * 128 + 16 * wave + lr] = acc[reg]; }
#pragma unroll
        for (int kb = 0; kb < 8; ++kb) { f32x4 acc = (f32x4){0.f, 0.f, 0.f, 0.f};
#pragma unroll
            for (int ks = 0; ks < 2; ++ks) { const bf16x8 bfr = *(const LAS bf16x8*)(KET + (16 * kb + lr) * 72 + 32 * ks + 8 * lq); acc = __builtin_amdgcn_mfma_f32_16x16x32_bf16(vb[ks], bfr, acc, 0, 0, 0); }
#pragma unroll
            for (int reg = 0; reg < 4; ++reg) { const float other = __shfl_xor(acc[reg], 1); if ((lr & 1) == 0) *(GAS unsigned*)(ST + (16 * wave + 4 * lq + reg) * 128 + 16 * kb + lr) = pk2(acc[reg], other); } }
    }
}
__device__ __forceinline__ void phase_hgrn_a(Frame& F, int l) { for (int u = F.vcu; u < 2048; u += F.G) hgrn_a_unit(F, l, u); __syncthreads(); }

__device__ __forceinline__ void phase_hgrn_b(Frame& F) {
    typedef float f32x2 __attribute__((ext_vector_type(2)));
    GAS bf16* STb = (GAS bf16*)(F.ws + WS_ST); const GAS float* DL = (const GAS float*)(F.ws + WS_DL);
    for (int idx = F.vcu * 512 + F.tid; idx < 16 * 8192; idx += F.G * 512) {
        const int chain = idx >> 13, e = (idx & 8191) * 2, k = e & 127; const size_t u0 = (size_t)chain * 128;
        f32x2 sv = (f32x2){0.f, 0.f};
#pragma unroll 1
        for (int c0 = 0; c0 < 128; c0 += 8) {
            unsigned tmp[8]; f32x2 d[8];
#pragma unroll
            for (int j = 0; j < 8; ++j) { tmp[j] = *(const GAS unsigned*)(STb + (u0 + c0 + j) * 16384 + e); d[j] = *(const GAS f32x2*)(DL + (u0 + c0 + j) * 128 + k); }
#pragma unroll
            for (int j = 0; j < 8; ++j) { *(GAS unsigned*)(STb + (u0 + c0 + j) * 16384 + e) = pk2(sv.x, sv.y); sv = d[j] * sv + (f32x2){bflo(tmp[j]), bfhi(tmp[j])}; }
        }
    }
}
__device__ __forceinline__ void hgrn_c_unit(Frame& F, int u) {
    int t = F.tid; asm volatile("" : "+v"(t));
    const int c = u & 127, bh = u >> 7, b = bh >> 3, h = bh & 7;
    const int lane = t & 63, wave = F.wave, lr = lane & 15, lq = lane >> 4;
    const size_t m0 = (size_t)b * SEQ + 64 * c;
    LAS bf16* QGs = (LAS bf16*)(F.lds); LAS bf16* STs = (LAS bf16*)(F.lds + 17408);
    GAS float* MR = (GAS float*)(F.ws + WS_MIXRAW); const GAS bf16* ST = (const GAS bf16*)(F.ws + WS_ST) + (size_t)u * 16384; const GAS bf16* QG = (const GAS bf16*)(F.ws + WS_QG);
    __syncthreads();
#pragma unroll
    for (int r = 0; r < 2; ++r) { const int v = t + 512 * r, row = v >> 4, cv = v & 15; *(LAS v4u*)(QGs + row * 136 + cv * 8) = *(const GAS v4u*)(QG + (m0 + row) * 1024 + h * 128 + cv * 8); }
#pragma unroll
    for (int r = 0; r < 4; ++r) { const int v = t + 512 * r, row = v >> 4, cv = v & 15; *(LAS v4u*)(STs + row * 136 + cv * 8) = *(const GAS v4u*)(ST + row * 128 + cv * 8); }
    __syncthreads();
    bf16x8 bfr[4];
#pragma unroll
    for (int ks = 0; ks < 4; ++ks) bfr[ks] = *(const LAS bf16x8*)(STs + (16 * wave + lr) * 136 + 32 * ks + 8 * lq);
#pragma unroll
    for (int rb = 0; rb < 4; ++rb) { f32x4 acc = (f32x4){0.f, 0.f, 0.f, 0.f};
#pragma unroll
        for (int ks = 0; ks < 4; ++ks) { const bf16x8 af = *(const LAS bf16x8*)(QGs + (16 * rb + lr) * 136 + 32 * ks + 8 * lq); acc = __builtin_amdgcn_mfma_f32_16x16x32_bf16(af, bfr[ks], acc, 0, 0, 0); }
#pragma unroll
        for (int reg = 0; reg < 4; ++reg) { GAS float* p = MR + (m0 + 16 * rb + 4 * lq + reg) * DM + 2048 + h * 128 + 16 * wave + lr; *p += acc[reg]; } }
}
__device__ __forceinline__ void phase_hgrn_c(Frame& F) { for (int u = F.vcu; u < 2048; u += F.G) { if ((u & 127) != 0) hgrn_c_unit(F, u); } __syncthreads(); }
}

__device__ __forceinline__ void phase_mixers(Frame& F, int l, unsigned char* lds_generic) {
    const GAS bf16* H = (const GAS bf16*)(F.ws + WS_H); const GAS bf16* Q = (const GAS bf16*)(F.ws + WS_Q); const GAS bf16* KN = (const GAS bf16*)(F.ws + WS_KN); const GAS bf16* V = (const GAS bf16*)(F.ws + WS_V); const GAS bf16* KPE = (const GAS bf16*)(F.ws + WS_KPE);
    GAS bf16* MA = (GAS bf16*)(F.ws + WS_MIXRAW);
    hg::phase_hgrn_c(F);
    for (int p = F.vcu; p < 512; p += F.G) { const int bh = p >> 4, i = p & 15, b = bh >> 4, h = bh & 15; const size_t r0 = (size_t)b * SEQ;
_Pragma("unroll 1")
        for (int half = 0; half < 2; ++half) { const int qb = half ? i : 31 - i;
            att::attn_unit<false>(Q + (r0 + 256 * qb) * 3072 + h * 192, KN + r0 * 2048 + h * 128, KPE + r0 * 64, V + r0 * 2048 + h * 128, MA + (r0 + 256 * qb) * 8192 + h * 128, 8192, qb, nullptr, (char*)lds_generic, F.tid); } }
    __syncthreads();
    const GAS float* rb = INP(12) + (size_t)l * 8 * 513;
    for (int p = F.vcu; p < 512; p += F.G) { const int qb = 31 - (p >> 4), bh = p & 15, b = bh >> 3, h = bh & 7; const size_t r0 = (size_t)b * SEQ; const GAS bf16* hb = H + r0 * D_IN_PAD + h * 128;
        att::attn_unit<true>(hb + (size_t)(256 * qb) * D_IN_PAD + OFF_AQ, hb + OFF_AK, nullptr, hb + OFF_AV, MA + (r0 + 256 * qb) * 8192 + 2048 + h * 128, 8192, qb, rb + h * 513, (char*)lds_generic, F.tid); }
    __syncthreads();
}
__device__ __forceinline__ void phase_mixnorm(Frame& F, int l) {
    const int gw = F.vcu * NWAVES + F.wave, NGW = F.G * NWAVES;
    const GAS float* MR = (const GAS float*)(F.ws + WS_MIXRAW); const GAS bf16* H = (const GAS bf16*)(F.ws + WS_H); GAS bf16* MIX = (GAS bf16*)(F.ws + WS_MIX);
    const GAS float* g_mla = INP(9) + (size_t)l * 2048; const GAS float* g_hg = INP(11) + (size_t)l * 1024; const GAS float* g_ca = INP(13) + (size_t)l * 1024;
    for (int m = gw; m < M; m += NGW) {
        const GAS float* r = MR + (size_t)m * DM; GAS bf16* o = MIX + (size_t)m * DM;
        const GAS bf16* ra = (const GAS bf16*)(F.ws + WS_MIXRAW) + (size_t)m * 8192;
        { f32x4 v[8]; float s = 0.f;
#pragma unroll
          for (int j = 0; j < 8; ++j) { const v2u w = *(const GAS v2u*)(ra + 256 * j + 4 * F.lane); v[j] = (f32x4){bflo(w.x), bfhi(w.x), bflo(w.y), bfhi(w.y)}; s += (v[j].x * v[j].x + v[j].y * v[j].y) + (v[j].z * v[j].z + v[j].w * v[j].w); }
          const float rstd = 1.0f / sqrtf(wave_sum(s) * (1.f / 2048.f) + EPS);
#pragma unroll
          for (int j = 0; j < 8; ++j) { const f32x4 g = *(const GAS f32x4*)(g_mla + 256 * j + 4 * F.lane); v2u w; w.x = pk2(v[j].x * rstd * g.x, v[j].y * rstd * g.y); w.y = pk2(v[j].z * rstd * g.z, v[j].w * rstd * g.w);
              *(GAS v2u*)(o + 256 * j + 4 * F.lane) = w; } }
        { f32x4 v[4];
#pragma unroll
          for (int j = 0; j < 4; ++j) { v[j] = *(const GAS f32x4*)(r + 2048 + 256 * j + 4 * F.lane); float s = (v[j].x * v[j].x + v[j].y * v[j].y) + (v[j].z * v[j].z + v[j].w * v[j].w);
              s += __shfl_xor(s, 1); s += __shfl_xor(s, 2); s += __shfl_xor(s, 4); s += __shfl_xor(s, 8); s += __shfl_xor(s, 16);
              const float rstd = 1.0f / sqrtf(s * (1.f / 128.f) + EPS);
              const f32x4 g = *(const GAS f32x4*)(g_hg + 256 * j + 4 * F.lane); const v2u gw2 = *(const GAS v2u*)(H + (size_t)m * D_IN_PAD + OFF_HG + 256 * j + 4 * F.lane);
              const float g0 = bflo(gw2.x), g1 = bfhi(gw2.x), g2 = bflo(gw2.y), g3 = bfhi(gw2.y);
              v2u w; w.x = pk2(v[j].x * rstd * g.x * (g0 / (1.0f + expf(-g0))), v[j].y * rstd * g.y * (g1 / (1.0f + expf(-g1)))); w.y = pk2(v[j].z * rstd * g.z * (g2 / (1.0f + expf(-g2))), v[j].w * rstd * g.w * (g3 / (1.0f + expf(-g3))));
              *(GAS v2u*)(o + 2048 + 256 * j + 4 * F.lane) = w; } }
        { f32x4 v[4]; float s = 0.f;
#pragma unroll
          for (int j = 0; j < 4; ++j) { const v2u w = *(const GAS v2u*)(ra + 2048 + 256 * j + 4 * F.lane); v[j] = (f32x4){bflo(w.x), bfhi(w.x), bflo(w.y), bfhi(w.y)}; s += (v[j].x * v[j].x + v[j].y * v[j].y) + (v[j].z * v[j].z + v[j].w * v[j].w); }
          const float rstd = 1.0f / sqrtf(wave_sum(s) * (1.f / 1024.f) + EPS);
#pragma unroll
          for (int j = 0; j < 4; ++j) { const f32x4 g = *(const GAS f32x4*)(g_ca + 256 * j + 4 * F.lane); v2u w; w.x = pk2(v[j].x * rstd * g.x, v[j].y * rstd * g.y); w.y = pk2(v[j].z * rstd * g.z, v[j].w * rstd * g.w);
              *(GAS v2u*)(o + 3072 + 256 * j + 4 * F.lane) = w; } }
    }
}

template <int l>
__device__ __forceinline__ void layer_phases(Frame& F, const XcdBarrier& bar, const int lo, const int hi, unsigned char* lds) {
#define IN(k) (lo <= (k) && (k) < hi)
#define SEAM(k) do { if (IN(k) && IN((k) + 1)) xcd_barrier(bar); } while (0)
#define FRESH() do { int t_ = F.wave * 64 + lane_id(); asm volatile("" : "+v"(t_)); F.tid = t_; F.lane = t_ & 63; asm volatile("" : "+s"(F.ws)); } while (0)
        const int pb = 1 + 10 * l;
        if (IN(pb + 0)) { FRESH(); { pg8::Gemm g{(const GAS bf16*)(F.ws + WS_XN), (const GAS bf16*)(F.ws + WS_WIN), M, D_IN_PAD, DM}; pg8::StaticOrder S; S.init(M, D_IN_PAD, F.G, (int)blockIdx.x);
            pg8::EpiH E{(GAS bf16*)(F.ws + WS_H), D_IN_PAD, (const GAS float*)(F.ws + WS_RS1)};
            pg8::gemm_phase<pg8::EpiH, pg8::StaticOrder, true, true>(F.lds + RING_OFF, g, S, E, F.tid); } }
        SEAM(pb + 0);
        if (IN(pb + 1)) { FRESH(); phase_n2(F, l); hg::phase_hgrn_a(F, l); }
        SEAM(pb + 1);
        if (IN(pb + 2)) { FRESH();
            { pg8::Gemm g{(const GAS bf16*)(F.ws + WS_CQN), (const GAS bf16*)(F.ws + WS_WUQ), M, 3072, 768}; pg8::StaticOrder S; S.init(M, 3072, F.G, (int)blockIdx.x);
              pg8::EpiQ E{(GAS bf16*)(F.ws + WS_Q), (const GAS float*)(F.ws + WS_ROPE), 0.07216878364870322f * LOG2E};
              pg8::gemm_phase<pg8::EpiQ, pg8::StaticOrder, true, true>(F.lds + RING_OFF, g, S, E, F.tid); }
            __syncthreads();
            { pg8::Gemm g{(const GAS bf16*)(F.ws + WS_CKVN), (const GAS bf16*)(F.ws + WS_WUKV), M, 4096, 512}; pg8::StaticOrder S; S.init(M, 4096, F.G, (int)blockIdx.x);
              pg8::EpiKV E{(GAS bf16*)(F.ws + WS_KN), (GAS bf16*)(F.ws + WS_V)};
              pg8::gemm_phase<pg8::EpiKV, pg8::StaticOrder, true, true>(F.lds + RING_OFF, g, S, E, F.tid); }
            __syncthreads();
            hg::phase_hgrn_b(F);
        }
        SEAM(pb + 2);
        if (IN(pb + 3)) { FRESH(); phase_mixers(F, l, lds); }
        SEAM(pb + 3);
        if (IN(pb + 4)) { FRESH(); phase_mixnorm(F, l); }
        SEAM(pb + 4);
        if (IN(pb + 5)) { FRESH(); { pg8::Gemm g{(const GAS bf16*)(F.ws + WS_MIX), (const GAS bf16*)(F.ws + WS_WOUT), M, DM, DM}; pg8::StaticOrder S; S.init(M, DM, F.G, (int)blockIdx.x);
            pg8::EpiH E{(GAS bf16*)(F.ws + WS_Y), DM, nullptr};
            pg8::gemm_phase<pg8::EpiH, pg8::StaticOrder, true, true>(F.lds + RING_OFF, g, S, E, F.tid); } }
        SEAM(pb + 5);
        if (IN(pb + 6)) { FRESH(); phase_resid(F, INP(3) + (size_t)l * DM, (GAS float*)(F.ws + WS_RS2), (GAS float*)nullptr); }
        SEAM(pb + 6);
        if (IN(pb + 7)) { FRESH(); { pg8::Gemm g{(const GAS bf16*)(F.ws + WS_XN), (const GAS bf16*)(F.ws + WS_WGU), M, 2 * DFF, DM}; pg8::StaticOrder S; S.init(M, 2 * DFF, F.G, (int)blockIdx.x);
            pg8::EpiSwiGLU E{(GAS bf16*)(F.ws + WS_ACT), DFF, (const GAS float*)(F.ws + WS_RS2)};
            pg8::gemm_phase<pg8::EpiSwiGLU, pg8::StaticOrder, true, true>(F.lds + RING_OFF, g, S, E, F.tid); } }
        SEAM(pb + 7);
        if (IN(pb + 8)) { FRESH(); { pg8::Gemm g{(const GAS bf16*)(F.ws + WS_ACT), (const GAS bf16*)(F.ws + WS_WD), M, DM, DFF}; pg8::StaticOrder S; S.init(M, DM, F.G, (int)blockIdx.x);
            pg8::EpiH E{(GAS bf16*)(F.ws + WS_Y), DM, nullptr};
            pg8::gemm_phase<pg8::EpiH, pg8::StaticOrder, true, true>(F.lds + RING_OFF, g, S, E, F.tid); } }
        SEAM(pb + 8);
        if (IN(pb + 9)) { FRESH(); { CArgs ap = argp(); phase_resid(F, (const GAS float*)ap->in[16] + (size_t)l * DM, (l + 1 < DEPTH) ? (GAS float*)(F.ws + WS_RS1) : (GAS float*)nullptr, (l + 1 < DEPTH) ? (GAS float*)nullptr : (GAS float*)ap->out); }
            if (l + 1 < DEPTH) convert_weights(F, l + 1); }
        SEAM(pb + 9);
#undef IN
#undef SEAM
#undef FRESH
}
__global__ void __launch_bounds__(NWAVES * 64, 2) mk_fwd(Args args) {
    extern __shared__ __attribute__((aligned(16))) unsigned char lds[];
    Frame F;
    F.lds = (LAS unsigned char*)lds;
    F.MISC = (volatile LAS unsigned*)(F.lds + MISC_OFF);
    F.tid = threadIdx.x; F.lane = F.tid & 63; F.wave = __builtin_amdgcn_readfirstlane(F.tid >> 6);
    F.G = gridDim.x; { const int bx = blockIdx.x; F.vcu = (F.G % 8 == 0) ? (bx % 8) * (F.G / 8) + bx / 8 : bx; }
    F.ws = (GAS unsigned char*)args.ws; F.ctl = (gu32*)(F.ws + WS_CTL);
    for (int u = F.tid; u < (LDS_BYTES - LDSCTL_OFF) / 4; u += NWAVES * 64) ((LAS unsigned*)(F.lds + LDSCTL_OFF))[u] = 0u;
    __syncthreads();
    XcdBarrier bar = xcd_barrier_post((unsigned*)(F.ctl + CW_BAR) + args.li * XCD_BAR_WORDS, F.MISC + 8, F.wave);
    const int lo = args.ph_lo, hi = args.ph_hi;
#define IN(k) (lo <= (k) && (k) < hi)
#define FRESH() do { int t_ = F.wave * 64 + lane_id(); asm volatile("" : "+v"(t_)); F.tid = t_; F.lane = t_ & 63; asm volatile("" : "+s"(F.ws)); } while (0)
#define SEAM(k) do { if (IN(k) && IN((k) + 1)) xcd_barrier(bar); } while (0)

    if (IN(0)) { FRESH(); convert_weights(F, 0); make_tables(F); phase_n1(F, INP(0)); }
    SEAM(0);
    layer_phases<0>(F, bar, lo, hi, lds);
    layer_phases<1>(F, bar, lo, hi, lds);
#undef IN
#undef FRESH
#undef SEAM
}

extern "C" void kernel_launch(void* const* d_in, const int* in_sizes, int n_in, void* d_out, int out_size, void* d_ws, size_t ws_size, hipStream_t stream) {
    static int grid = 0;
    if (grid == 0) {
        if (n_in != 20 || in_sizes[0] != M * DM || out_size != M * DM || ws_size < WS_END) { fprintf(stderr, "kernel_launch: shape/workspace mismatch (n_in %d, in0 %d, out %d, ws %zu, need %zu)\n", n_in, n_in > 0 ? in_sizes[0] : -1, out_size, ws_size, (size_t)WS_END); grid = -1; return; }
        int dev = 0, cus = 0, per_cu = 0;
        if (hipGetDevice(&dev) != hipSuccess || hipDeviceGetAttribute(&cus, hipDeviceAttributeMultiprocessorCount, dev) != hipSuccess) { grid = -1; return; }
        if (hipFuncSetAttribute((const void*)mk_fwd, hipFuncAttributeMaxDynamicSharedMemorySize, LDS_BYTES) != hipSuccess) { fprintf(stderr, "kernel_launch: hipFuncSetAttribute failed\n"); grid = -1; return; }
        if (hipOccupancyMaxActiveBlocksPerMultiprocessor(&per_cu, (const void*)mk_fwd, NWAVES * 64, LDS_BYTES) != hipSuccess || per_cu < 1) fprintf(stderr, "kernel_launch: occupancy query says %d\n", per_cu);
        (void)hipGetLastError();
        grid = cus;
    }
    if (grid < 0) return;
    if (hipMemsetAsync((char*)d_ws + WS_CTL, 0, CTL_ZERO_BYTES, stream) != hipSuccess) return;
    Args a{};
    for (int i = 0; i < 20; ++i) a.in[i] = (const float*)d_in[i];
    a.out = (float*)d_out; a.ws = (unsigned char*)d_ws; a.pad = 0;
#if MK_PER_PHASE
    for (int p = 0; p < NPH; ++p) { a.ph_lo = p; a.ph_hi = p + 1; a.li = p;
        hipLaunchKernelGGL(mk_fwd, dim3(grid), dim3(NWAVES * 64), LDS_BYTES, stream, a); }
#else
    a.ph_lo = 0; a.ph_hi = NPH; a.li = 0;
    hipLaunchKernelGGL(mk_fwd, dim3(grid), dim3(NWAVES * 64), LDS_BYTES, stream, a);
#endif
    const hipError_t le = hipPeekAtLastError();
    if (le != hipSuccess) fprintf(stderr, "kernel_launch: launch failed: %s\n", hipGetErrorName(le));
}
```

```cpp
#include <hip/hip_runtime.h>
#include <cstdio>
#include <cstdint>
namespace pg8 {
#define PG8_LAS __attribute__((address_space(3)))
#define PG8_GAS __attribute__((address_space(1)))
typedef unsigned short bf16_t;
typedef short bf16x8 __attribute__((ext_vector_type(8)));
typedef float f32x4 __attribute__((ext_vector_type(4)));
typedef unsigned u32x4 __attribute__((ext_vector_type(4)));
constexpr int BM = 256, BK = 64, HALF = 128, HTB = HALF * BK * 2  , STAGE_BYTES = 8 * HTB, NXCD = 8, WGM = 8;

__host__ __device__ __forceinline__ int lds_byte(int r, int c) { const int st = (r >> 4) * 2 + (c >> 5), rr = r & 15, cc = c & 31, ob = rr * 64 + cc * 2; return st * 1024 + (ob ^ (((ob >> 9) & 1) << 5)); }
__host__ __device__ __forceinline__ void stage_rc(int b, int& R, int& C) { const int st = b / 1024, sb = b % 1024, swz = sb ^ (((sb >> 9) & 1) << 5); R = (st >> 1) * 16 + swz / 64; C = (st & 1) * 32 + (swz % 64) / 2; }
__host__ __device__ __forceinline__ int perm32(int rho) { const int n = rho >> 4, i = rho & 15; return 8 * (i >> 2) + 4 * n + (i & 3); }

struct Unit { int pm, pn; };
struct Gemm { const PG8_GAS bf16_t* A; const PG8_GAS bf16_t* Bt; int M, N, K; };

struct StaticOrder {
    int nM, nN, nwg, G, c;
    __host__ __device__ void init(int M, int N, int G_, int c_) { nM = M / BM; nN = N / BM; nwg = nM * nN; G = G_; c = c_; }
    __host__ __device__ bool next(int i, Unit& u) const {
        const long L = (long)i * G + c; if (L >= nwg) return false;
        int wgid = (int)L; { const int q = nwg / NXCD, r = nwg % NXCD, xcd = wgid % NXCD, off = wgid / NXCD; wgid = (xcd < r ? xcd * (q + 1) : r * (q + 1) + (xcd - r) * q) + off; }
        const int nig = WGM * nN, gid = wgid / nig, fm = gid * WGM, gsz = (nM - fm) < WGM ? (nM - fm) : WGM;
        u.pm = fm + ((wgid % nig) % gsz); u.pn = (wgid % nig) / gsz; return true;
    }
    __device__ __forceinline__ void a_ready(const Unit&) const {}
    __device__ __forceinline__ void done(const Unit&) const {}
};


__device__ __forceinline__ unsigned cvt_pk_bf16(float lo, float hi) { unsigned r; asm volatile("v_cvt_pk_bf16_f32 %0, %1, %2" : "=v"(r) : "v"(lo), "v"(hi)); return r; }
__device__ __forceinline__ u32x4 pack8(const f32x4 v0, const f32x4 v1) { u32x4 w; w.x = cvt_pk_bf16(v0[0], v0[1]); w.y = cvt_pk_bf16(v0[2], v0[3]); w.z = cvt_pk_bf16(v1[0], v1[1]); w.w = cvt_pk_bf16(v1[2], v1[3]); return w; }

struct EpiF32 {
    static constexpr bool PERM = false, AFTER_DRAIN = false;
    PG8_GAS float* C; int ldc;
    __device__ __forceinline__ void operator()(const f32x4 (&acc)[2][2][4][2], const Unit& u, int wr, int wc, int fr, int fq) const {
        const int row0 = u.pm * BM + wr * 64 + fr, col0 = u.pn * BM + wc * 32 + 4 * fq;
#pragma unroll
        for (int ai = 0; ai < 2; ++ai)
#pragma unroll
            for (int m = 0; m < 4; ++m) { PG8_GAS float* rowp = C + (size_t)(row0 + ai * HALF + m * 16) * ldc + col0;
#pragma unroll
                for (int bj = 0; bj < 2; ++bj)
#pragma unroll
                    for (int n = 0; n < 2; ++n) *(PG8_GAS f32x4*)(rowp + bj * HALF + n * 16) = acc[ai][bj][m][n]; }
    }
};
struct EpiH {
    static constexpr bool PERM = true, AFTER_DRAIN = false;
    PG8_GAS bf16_t* O; int ldc; const PG8_GAS float* rs;
    __device__ __forceinline__ void operator()(const f32x4 (&acc)[2][2][4][2], const Unit& u, int wr, int wc, int fr, int fq) const {
        const int row0 = u.pm * BM + wr * 64 + fr, col0 = u.pn * BM + wc * 32 + 8 * fq;
#pragma unroll
        for (int ai = 0; ai < 2; ++ai)
#pragma unroll
            for (int m = 0; m < 4; ++m) { const int row = row0 + ai * HALF + m * 16; PG8_GAS bf16_t* rowp = O + (size_t)row * ldc + col0; const float sc = rs ? rs[row] : 1.0f;
#pragma unroll
                for (int bj = 0; bj < 2; ++bj) *(PG8_GAS u32x4*)(rowp + bj * HALF) = pack8(acc[ai][bj][m][0] * sc, acc[ai][bj][m][1] * sc); }
    }
};
struct EpiQ {
    static constexpr bool PERM = true, AFTER_DRAIN = false;
    PG8_GAS bf16_t* Q; const PG8_GAS float* rope; float qs;
    __device__ __forceinline__ void operator()(const f32x4 (&acc)[2][2][4][2], const Unit& u, int wr, int wc, int fr, int fq) const {
        const int row0 = u.pm * BM + wr * 64 + fr;
#pragma unroll
        for (int ai = 0; ai < 2; ++ai)
#pragma unroll
            for (int m = 0; m < 4; ++m) { const int row = row0 + ai * HALF + m * 16;
#pragma unroll
                for (int bj = 0; bj < 2; ++bj) {
                    f32x4 v0 = acc[ai][bj][m][0] * qs, v1 = acc[ai][bj][m][1] * qs;
                    PG8_GAS bf16_t* dst;
                    if (u.pn < 8) { const int h = 2 * u.pn + bj; dst = Q + (size_t)row * 3072 + h * 192 + wc * 32 + 8 * fq; }
                    else { const int cr = (u.pn - 8) * 256 + bj * HALF + wc * 32 + 8 * fq, h = cr >> 6, pos = cr & 63;
                        const PG8_GAS float* cs = rope + (size_t)row * 64 + pos;
                        const f32x4 c0 = *(const PG8_GAS f32x4*)cs, c1 = *(const PG8_GAS f32x4*)(cs + 4);
                        const f32x4 r0 = (f32x4){v0[0] * c0[0] - v0[1] * c0[1], v0[0] * c0[1] + v0[1] * c0[0], v0[2] * c0[2] - v0[3] * c0[3], v0[2] * c0[3] + v0[3] * c0[2]};
                        const f32x4 r1 = (f32x4){v1[0] * c1[0] - v1[1] * c1[1], v1[0] * c1[1] + v1[1] * c1[0], v1[2] * c1[2] - v1[3] * c1[3], v1[2] * c1[3] + v1[3] * c1[2]};
                        v0 = r0; v1 = r1; dst = Q + (size_t)row * 3072 + h * 192 + 128 + pos; }
                    *(PG8_GAS u32x4*)dst = pack8(v0, v1); } }
    }
};
struct EpiKV {
    static constexpr bool PERM = true, AFTER_DRAIN = false;
    PG8_GAS bf16_t* KN; PG8_GAS bf16_t* V;
    __device__ __forceinline__ void operator()(const f32x4 (&acc)[2][2][4][2], const Unit& u, int wr, int wc, int fr, int fq) const {
        const int row0 = u.pm * BM + wr * 64 + fr, col0 = u.pn * 128 + wc * 32 + 8 * fq;
#pragma unroll
        for (int ai = 0; ai < 2; ++ai)
#pragma unroll
            for (int m = 0; m < 4; ++m) { const size_t off = (size_t)(row0 + ai * HALF + m * 16) * 2048 + col0;
                *(PG8_GAS u32x4*)(KN + off) = pack8(acc[ai][0][m][0], acc[ai][0][m][1]);
                *(PG8_GAS u32x4*)(V + off) = pack8(acc[ai][1][m][0], acc[ai][1][m][1]); }
    }
};
__device__ __forceinline__ float silu_mul(float g, float up) { return g * __builtin_amdgcn_rcpf(1.0f + __builtin_amdgcn_exp2f(-1.4426950408889634f * g)) * up; }
struct EpiSwiGLU {
    static constexpr bool PERM = true, AFTER_DRAIN = false;
    PG8_GAS bf16_t* ACT; int ldc; const PG8_GAS float* rs;
    __device__ __forceinline__ void operator()(const f32x4 (&acc)[2][2][4][2], const Unit& u, int wr, int wc, int fr, int fq) const {
        const int row0 = u.pm * BM + wr * 64 + fr, col0 = u.pn * 128 + wc * 32 + 8 * fq;
#pragma unroll
        for (int ai = 0; ai < 2; ++ai)
#pragma unroll
            for (int m = 0; m < 4; ++m) { const int row = row0 + ai * HALF + m * 16; const float sc = rs[row];
                f32x4 r0, r1;
#pragma unroll
                for (int j = 0; j < 4; ++j) { r0[j] = silu_mul(acc[ai][0][m][0][j] * sc, acc[ai][1][m][0][j] * sc); r1[j] = silu_mul(acc[ai][0][m][1][j] * sc, acc[ai][1][m][1][j] * sc); }
                *(PG8_GAS u32x4*)(ACT + (size_t)row * ldc + col0) = pack8(r0, r1); }
    }
};

template <class Epi, class Sched, bool ALIGN_EPI = false, bool SP2 = false>
__device__ __forceinline__ void gemm_phase(PG8_LAS unsigned char* lds, const Gemm g, const Sched& S, const Epi& E, const int tid_in) {
    int tid_ = tid_in; asm volatile("" : "+v"(tid_));
    const int tid = tid_, wid = __builtin_amdgcn_readfirstlane(tid >> 6), lane = tid & 63, wr = wid >> 2, wc = wid & 3, fr = lane & 15, fq = lane >> 4;
    const int K = g.K, nt = K / BK;
    unsigned voffA[2], voffB[2];
#pragma unroll
    for (int i = 0; i < 2; ++i) { int R, C; stage_rc(tid * 16 + i * 8192, R, C); const int Rb = Epi::PERM ? ((R & ~31) + perm32(R & 31)) : R;
        voffA[i] = (unsigned)(R * K + C) * 2u; voffB[i] = (unsigned)(Rb * K + C) * 2u; }
    const size_t kstep = (size_t)(BK * 2);
    const size_t hstep = (size_t)HALF * K * 2;
    const size_t tstep = 2 * hstep;
    const unsigned ldsw = (unsigned)wid * 1024u;
    const int aoff = lds_byte(wr * 64 + fr, fq * 8), boff = lds_byte(wc * 32 + fr, fq * 8);
#define PG8_SA(b, h) (((b) * 2 + (h)) * HTB)
#define PG8_SB(b, h) ((4 + (b) * 2 + (h)) * HTB)
#define PG8_STAGE(bufoff, gbase, voff) do { _Pragma("unroll") for (int _i = 0; _i < 2; ++_i) \
        __builtin_amdgcn_global_load_lds((const PG8_GAS unsigned*)((const PG8_GAS char*)(gbase) + (voff)[_i]), (PG8_LAS unsigned*)(lds + (bufoff) + ldsw + _i * 8192), 16, 0, 0); } while (0)
#define PG8_LDA(dst, b, h) do { _Pragma("unroll") for (int m = 0; m < 4; ++m) _Pragma("unroll") for (int k = 0; k < 2; ++k) dst[m][k] = *(const PG8_LAS bf16x8*)(lds + PG8_SA(b, h) + aoff + m * 2048 + k * 1024); } while (0)
#define PG8_LDB(dst, b, h) do { _Pragma("unroll") for (int n = 0; n < 2; ++n) _Pragma("unroll") for (int k = 0; k < 2; ++k) dst[n][k] = *(const PG8_LAS bf16x8*)(lds + PG8_SB(b, h) + boff + n * 2048 + k * 1024); } while (0)
#define PG8_MMA(ai, bj, At, Bt) do { __builtin_amdgcn_s_setprio(1); _Pragma("unroll") for (int m = 0; m < 4; ++m) _Pragma("unroll") for (int n = 0; n < 2; ++n) _Pragma("unroll") for (int k = 0; k < 2; ++k) \
        acc[ai][bj][m][n] = __builtin_amdgcn_mfma_f32_16x16x32_bf16(Bt[n][k], At[m][k], acc[ai][bj][m][n], 0, 0, 0); __builtin_amdgcn_s_setprio(0); } while (0)
#define PG8_WAIT_V(n) asm volatile("s_waitcnt vmcnt(" #n ")" ::: "memory")
#define PG8_WAIT_L(n) asm volatile("s_waitcnt lgkmcnt(" #n ")" ::: "memory")
#define PG8_BAR __builtin_amdgcn_s_barrier()
#define PG8_SCHED __builtin_amdgcn_sched_barrier(0)
    Unit cur, nxt; int ui = 0;
    if (!S.next(0, cur)) return;
    f32x4 acc[2][2][4][2];
    float zf_ = 0.f; asm volatile("" : "+v"(zf_));
#pragma unroll
    for (int a = 0; a < 2; ++a)
#pragma unroll
        for (int b = 0; b < 2; ++b)
#pragma unroll
            for (int m = 0; m < 4; ++m)
#pragma unroll
                for (int n = 0; n < 2; ++n) acc[a][b][m][n] = (f32x4){zf_, zf_, zf_, zf_};
    bf16x8 At[4][2], B0[2][2], B1[2][2];
    const PG8_GAS char* cA = (const PG8_GAS char*)g.A + (size_t)cur.pm * tstep; const PG8_GAS char* cB = (const PG8_GAS char*)g.Bt + (size_t)cur.pn * tstep;
    S.a_ready(cur);
    if constexpr (SP2) {
        PG8_STAGE(PG8_SB(0, 0), cB, voffB); PG8_STAGE(PG8_SB(0, 1), cB + hstep, voffB); PG8_STAGE(PG8_SA(0, 0), cA, voffA); PG8_STAGE(PG8_SA(0, 1), cA + hstep, voffA);
        if (wr == 1) PG8_BAR;
        PG8_WAIT_V(2); PG8_BAR;
        PG8_STAGE(PG8_SB(1, 0), cB + kstep, voffB); PG8_STAGE(PG8_SA(1, 0), cA + kstep, voffA); PG8_STAGE(PG8_SB(1, 1), cB + hstep + kstep, voffB);
        PG8_WAIT_V(6); PG8_BAR;
    } else {
        PG8_STAGE(PG8_SB(0, 0), cB, voffB); PG8_STAGE(PG8_SA(0, 0), cA, voffA); PG8_STAGE(PG8_SB(0, 1), cB + hstep, voffB); PG8_STAGE(PG8_SA(0, 1), cA + hstep, voffA);
        if (wr == 1) PG8_BAR;
        PG8_WAIT_V(4); PG8_BAR;
        PG8_STAGE(PG8_SB(1, 0), cB + kstep, voffB); PG8_STAGE(PG8_SA(1, 0), cA + kstep, voffA); PG8_STAGE(PG8_SB(1, 1), cB + hstep + kstep, voffB);
        PG8_WAIT_V(6); PG8_BAR;
    }
    for (;;) {
        const bool has_next = S.next(ui + 1, nxt);
        const PG8_GAS char* nA = has_next ? (const PG8_GAS char*)g.A + (size_t)nxt.pm * tstep : cA; const PG8_GAS char* nB = has_next ? (const PG8_GAS char*)g.Bt + (size_t)nxt.pn * tstep : cB;
        for (int t = 0; t < nt; t += 2) {
            const bool last = (t == nt - 2);
            const PG8_GAS char* a1 = cA + (size_t)(t + 1) * kstep;
            const PG8_GAS char* a2 = last ? nA : cA + (size_t)(t + 2) * kstep; const PG8_GAS char* b2 = last ? nB : cB + (size_t)(t + 2) * kstep;
            const PG8_GAS char* a3 = a2 + kstep; const PG8_GAS char* b3 = b2 + kstep;
            if (last && has_next) S.a_ready(nxt);
            if constexpr (SP2) {
            PG8_LDB(B0, 0, 0); PG8_LDB(B1, 0, 1); PG8_SCHED; PG8_LDA(At, 0, 0); PG8_STAGE(PG8_SA(1, 1), a1 + hstep, voffA);
            PG8_WAIT_V(8); PG8_WAIT_L(0); PG8_BAR; PG8_MMA(0, 0, At, B0); PG8_MMA(0, 1, At, B1); PG8_BAR; PG8_SCHED;
            PG8_LDA(At, 0, 1); PG8_STAGE(PG8_SB(0, 0), b2, voffB); PG8_STAGE(PG8_SB(0, 1), b2 + hstep, voffB); PG8_STAGE(PG8_SA(0, 0), a2, voffA);
            PG8_WAIT_V(8); PG8_WAIT_L(0); PG8_BAR; PG8_MMA(1, 0, At, B0); PG8_MMA(1, 1, At, B1); PG8_BAR; PG8_SCHED;
            PG8_LDB(B0, 1, 0); PG8_LDB(B1, 1, 1); PG8_SCHED; PG8_LDA(At, 1, 0); PG8_STAGE(PG8_SA(0, 1), a2 + hstep, voffA);
            PG8_WAIT_V(8); PG8_WAIT_L(0); PG8_BAR; PG8_MMA(0, 0, At, B0); PG8_MMA(0, 1, At, B1); PG8_BAR; PG8_SCHED;
            PG8_LDA(At, 1, 1); PG8_STAGE(PG8_SB(1, 0), b3, voffB); PG8_STAGE(PG8_SB(1, 1), b3 + hstep, voffB); PG8_STAGE(PG8_SA(1, 0), a3, voffA);
            PG8_WAIT_V(8); PG8_WAIT_L(0); PG8_BAR; PG8_MMA(1, 0, At, B0); PG8_MMA(1, 1, At, B1); PG8_BAR; PG8_SCHED;
            } else {
            PG8_LDB(B0, 0, 0); PG8_SCHED; PG8_LDA(At, 0, 0); PG8_STAGE(PG8_SA(1, 1), a1 + hstep, voffA);
            PG8_WAIT_L(8); PG8_BAR; PG8_WAIT_L(0); PG8_MMA(0, 0, At, B0); PG8_BAR; PG8_SCHED;
            PG8_LDB(B1, 0, 1); PG8_STAGE(PG8_SB(0, 0), b2, voffB);
            PG8_BAR; PG8_WAIT_L(0); PG8_MMA(0, 1, At, B1); PG8_BAR;
            PG8_LDA(At, 0, 1); PG8_STAGE(PG8_SA(0, 0), a2, voffA);
            PG8_BAR; PG8_WAIT_L(0); PG8_MMA(1, 0, At, B0); PG8_BAR; PG8_SCHED;
            PG8_STAGE(PG8_SB(0, 1), b2 + hstep, voffB);
            PG8_WAIT_V(6); PG8_BAR; PG8_MMA(1, 1, At, B1); PG8_BAR;
            PG8_LDB(B0, 1, 0); PG8_SCHED; PG8_LDA(At, 1, 0); PG8_STAGE(PG8_SA(0, 1), a2 + hstep, voffA);
            PG8_WAIT_L(8); PG8_BAR; PG8_WAIT_L(0); PG8_MMA(0, 0, At, B0); PG8_BAR; PG8_SCHED;
            PG8_LDB(B1, 1, 1); PG8_STAGE(PG8_SB(1, 0), b3, voffB);
            PG8_BAR; PG8_WAIT_L(0); PG8_MMA(0, 1, At, B1); PG8_BAR;
            PG8_LDA(At, 1, 1); PG8_STAGE(PG8_SA(1, 0), a3, voffA);
            PG8_BAR; PG8_WAIT_L(0); PG8_MMA(1, 0, At, B0); PG8_BAR; PG8_SCHED;
            PG8_STAGE(PG8_SB(1, 1), b3 + hstep, voffB);
            PG8_WAIT_V(6); PG8_BAR; PG8_MMA(1, 1, At, B1); PG8_BAR;
            }
        }
        if constexpr (ALIGN_EPI) { if (wr == 0) PG8_BAR; }
        if constexpr (!Epi::AFTER_DRAIN) { E(acc, cur, wr, wc, fr, fq); S.done(cur); }
        if (!has_next) break;
#pragma unroll
        for (int a = 0; a < 2; ++a)
#pragma unroll
            for (int b = 0; b < 2; ++b)
#pragma unroll
                for (int m = 0; m < 4; ++m)
#pragma unroll
                    for (int n = 0; n < 2; ++n) acc[a][b][m][n] = (f32x4){zf_, zf_, zf_, zf_};
        cur = nxt; cA = nA; cB = nB; ++ui;
        if constexpr (ALIGN_EPI) { if (wr == 1) PG8_BAR; }
    }
    PG8_WAIT_V(0);
    if constexpr (!ALIGN_EPI) { if (wr == 0) PG8_BAR; }
    PG8_BAR;
    if constexpr (Epi::AFTER_DRAIN) { E.fused(acc, cur, wr, wc, fr, fq, lds, wid, lane); S.done(cur); }
#undef PG8_SA
#undef PG8_SB
#undef PG8_STAGE
#undef PG8_LDA
#undef PG8_LDB
#undef PG8_MMA
#undef PG8_WAIT_V
#undef PG8_WAIT_L
#undef PG8_BAR
#undef PG8_SCHED
}
}


constexpr int NWAVES = 8;
constexpr int BATCH = 2, SEQ = 8192, M = BATCH * SEQ, DM = 4096, DEPTH = 2;
constexpr int D_IN = 8512, D_IN_PAD = 8704, DFF = 11008;
constexpr int OFF_CQ = 0, OFF_CKV = 768, OFF_KR = 1280, OFF_HQ = 1344, OFF_HF = 2368, OFF_HI = 3392, OFF_HG = 4416, OFF_AQ = 5440, OFF_AK = 6464, OFF_AV = 7488;
constexpr float EPS = 1e-6f;
constexpr float LOG2E = 1.4426950408889634f;
constexpr int NPH = 1 + 10 * DEPTH;
#ifndef MK_PER_PHASE
#define MK_PER_PHASE 0
#endif

constexpr size_t MiB = 1u << 20;
constexpr size_t WS_CTL = 0, CTL_ZERO_BYTES = 1 * MiB;
constexpr size_t WS_ROPE = 2 * MiB;
constexpr size_t WS_LB = 6 * MiB;
constexpr size_t WS_WIN = 8 * MiB, WS_WUQ = 76 * MiB, WS_WUKV = 81 * MiB, WS_WOUT = 85 * MiB, WS_WGU = 117 * MiB, WS_WD = 289 * MiB;
constexpr size_t WS_XN = 375 * MiB;
constexpr size_t WS_H = 503 * MiB, WS_CQN = 775 * MiB, WS_CKVN = 799 * MiB, WS_KPE = 815 * MiB, WS_ACT = 503 * MiB;
constexpr size_t WS_Q = 847 * MiB, WS_KN = 943 * MiB, WS_V = 1007 * MiB, WS_Y = 847 * MiB;
constexpr size_t WS_MIXRAW = 1103 * MiB;
constexpr size_t WS_ST = 1359 * MiB;
constexpr size_t WS_QG = 1487 * MiB;
constexpr size_t WS_DL = 1519 * MiB;
constexpr size_t WS_MIX = 1520 * MiB;
constexpr size_t WS_RS1 = 1648 * MiB, WS_RS2 = 1649 * MiB;
constexpr size_t WS_END = 1650 * MiB;
static_assert(WS_WIN + (size_t)D_IN_PAD * DM * 2 <= WS_WUQ && WS_WUQ + (size_t)3072 * 768 * 2 <= WS_WUKV && WS_WUKV + (size_t)4096 * 512 * 2 <= WS_WOUT && WS_WOUT + (size_t)DM * DM * 2 <= WS_WGU &&
              WS_WGU + (size_t)2 * DFF * DM * 2 <= WS_WD && WS_WD + (size_t)DM * DFF * 2 <= WS_XN && WS_XN + (size_t)M * DM * 2 <= WS_H && WS_H + (size_t)M * D_IN_PAD * 2 <= WS_CQN &&
              WS_CQN + (size_t)M * 768 * 2 <= WS_CKVN && WS_CKVN + (size_t)M * 512 * 2 <= WS_KPE && WS_KPE + (size_t)M * 64 * 2 <= WS_Q && WS_ACT + (size_t)M * DFF * 2 <= WS_Q &&
              WS_Q + (size_t)M * 3072 * 2 <= WS_KN && WS_KN + (size_t)M * 2048 * 2 <= WS_V && WS_V + (size_t)M * 2048 * 2 <= WS_MIXRAW && WS_Y + (size_t)M * DM * 4 <= WS_MIXRAW &&
              WS_MIXRAW + (size_t)M * DM * 4 <= WS_ST && WS_ST + (size_t)2048 * 16384 * 4 <= WS_QG && WS_QG + (size_t)M * 1024 * 2 <= WS_DL && WS_DL + (size_t)2048 * 128 * 4 <= WS_END, "d_ws map");
constexpr int CW_BAR = 4096;

constexpr int RING_OFF = 0, RING_BYTES = 131072;
constexpr int LDSCTL_OFF = RING_BYTES, MISC_OFF = LDSCTL_OFF + 320;
constexpr int LDS_BYTES = 147456;

#define GAS __attribute__((address_space(1)))
#define LAS __attribute__((address_space(3)))
typedef unsigned short bf16;
typedef unsigned v4u __attribute__((ext_vector_type(4)));
typedef unsigned v2u __attribute__((ext_vector_type(2)));
typedef float f32x4 __attribute__((ext_vector_type(4)));
typedef GAS unsigned gu32;
#define RLX_AGENT __ATOMIC_RELAXED, __HIP_MEMORY_SCOPE_AGENT
#define LDS_WAIT() asm volatile("s_waitcnt lgkmcnt(0)" ::: "memory")
#define VM_WAIT() asm volatile("s_waitcnt vmcnt(0)" ::: "memory")
__device__ __forceinline__ float bf2f(unsigned b) { return __uint_as_float(b << 16); }
__device__ __forceinline__ float bflo(unsigned w) { return __uint_as_float(w << 16); }
__device__ __forceinline__ float bfhi(unsigned w) { return __uint_as_float(w & 0xffff0000u); }
__device__ __forceinline__ unsigned pk2(float lo, float hi) { return pg8::cvt_pk_bf16(lo, hi); }

#define XB_TMO      128
#define XB_XCNT(j)  (256  + 64 * (j))
#define XB_XSUB(j)  (1280 + 64 * (j))
#define XB_XGEN(j)  (2304 + 64 * (j))
#define XB_TOP      3328
#define XB_TOPGEN   3392
#define XCD_BAR_WORDS 3456
#define XB_SPIN_CAP (1u << 18)
__device__ __forceinline__ unsigned xb_ld(unsigned* p)              { return __hip_atomic_load(p, __ATOMIC_RELAXED, __HIP_MEMORY_SCOPE_AGENT); }
__device__ __forceinline__ unsigned xb_add(unsigned* p, unsigned v) { return __hip_atomic_fetch_add(p, v, __ATOMIC_RELAXED, __HIP_MEMORY_SCOPE_AGENT); }
__device__ __forceinline__ unsigned xb_xcc_id() { return (unsigned)__builtin_amdgcn_s_getreg((3 << 11) | 20) & 0xFu; }
#define XB_SPIN(cond, bar) do { unsigned _sp = 0; while (cond) { __builtin_amdgcn_s_sleep(1); \
    if ((++_sp & 255u) == 0u) { if (xb_ld(&(bar)[XB_TMO])) break; if (_sp > XB_SPIN_CAP) { atomicAdd(&(bar)[XB_TMO], 1u); break; } } } } while (0)
__device__ __forceinline__ int lane_id() { return (int)__builtin_amdgcn_mbcnt_hi(~0u, __builtin_amdgcn_mbcnt_lo(~0u, 0u)); }
struct XcdBarrier { unsigned* bar; unsigned x; volatile LAS unsigned* st; int wave; };
__device__ __forceinline__ XcdBarrier xcd_barrier_post(unsigned* bar, volatile LAS unsigned* st, int wave) {
    XcdBarrier b; b.bar = bar; b.x = xb_xcc_id(); b.st = st; b.wave = wave;
    if (wave == 0 && lane_id() == 0) (void)xb_add(&bar[XB_XCNT(b.x)], 1u);
    return b;
}
__device__ __forceinline__ void xcd_barrier_complete(unsigned* bar, unsigned x, unsigned& nloc, unsigned& nx) {
    const unsigned G = gridDim.x * gridDim.y * gridDim.z;
    unsigned sum, cnt, mine, sp = 0u;
    for (;;) {
        sum = 0u; cnt = 0u; mine = 0u;
#pragma unroll
        for (unsigned j = 0; j < 16; ++j) { const unsigned c = xb_ld(&bar[XB_XCNT(j)]); sum += c; cnt += (c > 0u) ? 1u : 0u; mine = (j == x) ? c : mine; }
        if (sum == G) break;
        __builtin_amdgcn_s_sleep(1);
        if ((++sp & 255u) == 0u) { if (xb_ld(&bar[XB_TMO])) break; if (sp > XB_SPIN_CAP) { atomicAdd(&bar[XB_TMO], 1u); break; } }
    }
    nloc = mine > 0u ? mine : 1u; nx = cnt > 0u ? cnt : 1u;
}
__device__ __forceinline__ void xcd_barrier(const XcdBarrier& b) {
    asm volatile("s_waitcnt vmcnt(0)" ::: "memory");
    __syncthreads();
    if (b.wave == 0 && lane_id() == 0) {
        unsigned* bar = b.bar;
        __builtin_amdgcn_s_waitcnt(0);
        unsigned nloc = b.st[0], nx = b.st[1];
        if (nloc == 0u) { xcd_barrier_complete(bar, b.x, nloc, nx); b.st[0] = nloc; b.st[1] = nx; }
        const unsigned old = xb_add(&bar[XB_XSUB(b.x)], 1u);
        const unsigned gen = old / nloc;
        if (old + 1u == (gen + 1u) * nloc) {
            __builtin_amdgcn_fence(__ATOMIC_RELEASE, "agent");
            asm volatile("s_waitcnt vmcnt(0)" ::: "memory");
            const unsigned og = xb_add(&bar[XB_TOP], 1u);
            const unsigned tg = og / nx;
            if (og + 1u == (tg + 1u) * nx) xb_add(&bar[XB_TOPGEN], 1u);
            else XB_SPIN(xb_ld(&bar[XB_TOPGEN]) == tg, bar);
            __builtin_amdgcn_fence(__ATOMIC_ACQUIRE, "agent");
            xb_add(&bar[XB_XGEN(b.x)], 1u);
            asm volatile("s_waitcnt vmcnt(0)" ::: "memory");
        } else {
            XB_SPIN(xb_ld(&bar[XB_XGEN(b.x)]) == gen, bar);
            __builtin_amdgcn_fence(__ATOMIC_ACQUIRE, "agent");
            asm volatile("s_waitcnt vmcnt(0)" ::: "memory");
        }
    }
    __syncthreads();
}

struct Frame {
    LAS unsigned char* lds;
    volatile LAS unsigned* MISC;
    gu32* ctl;
    int tid, lane, wave;
    int vcu, G;
    GAS unsigned char* ws;
};
struct Args { const float* in[20]; float* out; unsigned char* ws; int ph_lo, ph_hi, li, pad; };
typedef const __attribute__((address_space(4))) Args* CArgs;
__device__ __forceinline__ CArgs argp() { CArgs p = (CArgs)__builtin_amdgcn_kernarg_segment_ptr(); asm volatile("" : "+s"(p)); return p; }
#define INP(i) ((const GAS float*)(argp()->in[i]))
__device__ __forceinline__ float wave_sum(float v) {
#pragma unroll
    for (int o = 1; o < 64; o <<= 1) v += __shfl_xor(v, o);
    return v;
}

enum { MAP_ID = 0, MAP_UQ = 1, MAP_GATE = 2, MAP_UP = 3 };
__device__ __forceinline__ int map_row(int map, int n) {
    if (map == MAP_UQ) { const int h = n / 192, j = n % 192; if (j < 128) return h * 128 + j; const int i = j - 128; const int pos = (i < 32) ? 2 * i : 2 * (i - 32) + 1; return 2048 + h * 64 + pos; }
    if (map == MAP_GATE) return (n >> 7) * 256 + (n & 127);
    if (map == MAP_UP) return (n >> 7) * 256 + 128 + (n & 127);
    return n;
}
struct CvItem { const GAS float* W; GAS bf16* WT; const GAS float* gk; int K, N, map, k0, n0; };
__device__ __forceinline__ CvItem cv_item(Frame& F, int l, int it) {
    constexpr int I_IN = (DM / 64) * (D_IN / 32), I_UQ = (768 / 64) * (3072 / 32), I_UKV = (512 / 64) * (4096 / 32), I_OUT = (DM / 64) * (DM / 32), I_G = (DM / 64) * (DFF / 32);
    CvItem c; int r = it; c.gk = nullptr; c.map = MAP_ID;
    if (r < I_IN) { c.W = INP(4) + (size_t)l * DM * D_IN; c.WT = (GAS bf16*)(F.ws + WS_WIN); c.K = DM; c.N = D_IN; c.gk = INP(2) + (size_t)l * DM; }
    else if ((r -= I_IN) < I_UQ) { c.W = INP(7) + (size_t)l * 768 * 3072; c.WT = (GAS bf16*)(F.ws + WS_WUQ); c.K = 768; c.N = 3072; c.map = MAP_UQ; }
    else if ((r -= I_UQ) < I_UKV) { c.W = INP(8) + (size_t)l * 512 * 4096; c.WT = (GAS bf16*)(F.ws + WS_WUKV); c.K = 512; c.N = 4096; }
    else if ((r -= I_UKV) < I_OUT) { c.W = INP(14) + (size_t)l * DM * DM; c.WT = (GAS bf16*)(F.ws + WS_WOUT); c.K = DM; c.N = DM; }
    else if ((r -= I_OUT) < I_G) { c.W = INP(17) + (size_t)l * DM * DFF; c.WT = (GAS bf16*)(F.ws + WS_WGU); c.K = DM; c.N = DFF; c.map = MAP_GATE; c.gk = INP(15) + (size_t)l * DM; }
    else if ((r -= I_G) < I_G) { c.W = INP(18) + (size_t)l * DM * DFF; c.WT = (GAS bf16*)(F.ws + WS_WGU); c.K = DM; c.N = DFF; c.map = MAP_UP; c.gk = INP(15) + (size_t)l * DM; }
    else { r -= I_G; c.W = INP(19) + (size_t)l * DFF * DM; c.WT = (GAS bf16*)(F.ws + WS_WD); c.K = DFF; c.N = DM; }
    const int nblk = c.N / 32; c.k0 = 64 * ((r / (4 * nblk)) * 4 + (r & 3)); c.n0 = 32 * ((r >> 2) % nblk);
    return c;
}
__device__ __forceinline__ void cv_load(const CvItem& c, int lane, f32x4 (&v)[8], f32x4& ga, f32x4& gb) {
    const int kr = lane >> 3, c4 = lane & 7;
#pragma unroll
    for (int i = 0; i < 8; ++i) v[i] = __builtin_nontemporal_load((const GAS f32x4*)(c.W + (size_t)(c.k0 + 8 * i + kr) * c.N + c.n0 + 4 * c4));
    ga = (f32x4){1.f, 1.f, 1.f, 1.f}; gb = ga; if (c.gk) { ga = *(const GAS f32x4*)(c.gk + c.k0 + 8 * (lane & 7)); gb = *(const GAS f32x4*)(c.gk + c.k0 + 8 * (lane & 7) + 4); }
}
__device__ __forceinline__ void cv_store(const CvItem& c, int lane, LAS float* scr, const f32x4 (&v)[8], const f32x4 ga, const f32x4 gb) {
    { const int kr = lane >> 3, c4 = lane & 7;
#pragma unroll
      for (int i = 0; i < 8; ++i) { LAS float* d = scr + (8 * i + kr) * 33 + 4 * c4; d[0] = v[i].x; d[1] = v[i].y; d[2] = v[i].z; d[3] = v[i].w; } }
    LDS_WAIT(); asm volatile("" ::: "memory");
    const int cc = lane & 7;
#pragma unroll
    for (int j = 0; j < 4; ++j) { const int n = (lane >> 3) + 8 * j; const LAS float* s = scr + (8 * cc) * 33 + n;
        v4u o; o.x = pk2(s[0 * 33] * ga.x, s[1 * 33] * ga.y); o.y = pk2(s[2 * 33] * ga.z, s[3 * 33] * ga.w); o.z = pk2(s[4 * 33] * gb.x, s[5 * 33] * gb.y); o.w = pk2(s[6 * 33] * gb.z, s[7 * 33] * gb.w);
        *(GAS v4u*)(c.WT + (size_t)map_row(c.map, c.n0 + n) * c.K + c.k0 + 8 * cc) = o; }
    LDS_WAIT(); asm volatile("" ::: "memory");
}
__device__ __forceinline__ void convert_weights(Frame& F, int l) {
    LAS float* scr = (LAS float*)(F.lds + RING_OFF + F.wave * 16384);
    const int gw = F.vcu * NWAVES + F.wave, NGW = F.G * NWAVES;
    constexpr int NITEMS = (DM / 64) * (D_IN / 32) + (768 / 64) * (3072 / 32) + (512 / 64) * (4096 / 32) + (DM / 64) * (DM / 32) + 2 * (DM / 64) * (DFF / 32) + (DFF / 64) * (DM / 32);
    int it = gw;
    if (it < NITEMS) {
        CvItem cur = cv_item(F, l, it); f32x4 v[8], ga, gb; cv_load(cur, F.lane, v, ga, gb);
        for (;;) {
            const int nx = it + NGW; const bool has = nx < NITEMS;
            CvItem nxt = cur; f32x4 w[8], ha = ga, hb = gb;
            if (has) { nxt = cv_item(F, l, nx); cv_load(nxt, F.lane, w, ha, hb); }
            cv_store(cur, F.lane, scr, v, ga, gb);
            if (!has) break;
            cur = nxt; ga = ha; gb = hb; it = nx;
#pragma unroll
            for (int i = 0; i < 8; ++i) v[i] = w[i];
        }
    }
    { GAS v4u* z = (GAS v4u*)((GAS bf16*)(F.ws + WS_WIN) + (size_t)D_IN * DM); const int nz = (D_IN_PAD - D_IN) * DM * 2 / 16;
      for (int i = F.vcu * 512 + F.tid; i < nz; i += F.G * 512) z[i] = (v4u){0u, 0u, 0u, 0u}; }
}
__device__ __forceinline__ void make_tables(Frame& F) {
    const GAS int* pos = (const GAS int*)INP(1); GAS float* rope = (GAS float*)(F.ws + WS_ROPE); GAS float* LB = (GAS float*)(F.ws + WS_LB); const GAS float* lbraw = INP(10);
    for (int idx = F.vcu * 512 + F.tid; idx < M * 32; idx += F.G * 512) {
        const int m = idx >> 5, i = idx & 31;
        const float e = (-18.420680743952367f * (float)i) / 64.0f;
        const float inv_freq = (float)exp((double)e);
        const float ang = (float)pos[m] * inv_freq;
        const double rev = (double)ang * 0.15915494309189535;
        const float fr = (float)(rev - rint(rev));
        rope[(size_t)idx * 2] = __builtin_amdgcn_cosf(fr); rope[(size_t)idx * 2 + 1] = __builtin_amdgcn_sinf(fr);
    }
    for (int c = F.vcu * 512 + F.tid; c < 1024; c += F.G * 512) { const float a0 = lbraw[c], a1 = lbraw[1024 + c]; LB[c] = 0.f; LB[1024 + c] = 1.0f / (1.0f + expf(a0 - a1)); }
}
__device__ __forceinline__ void phase_n1(Frame& F, const GAS float* x) {
    const int gw = F.vcu * NWAVES + F.wave, NGW = F.G * NWAVES; GAS bf16* X = (GAS bf16*)(F.ws + WS_XN); GAS float* RS1 = (GAS float*)(F.ws + WS_RS1);
    for (int m = gw; m < M; m += NGW) {
        const GAS f32x4* xr = (const GAS f32x4*)(x + (size_t)m * DM) + F.lane; GAS v2u* o8 = (GAS v2u*)(X + (size_t)m * DM) + F.lane;
        f32x4 v[16]; float s = 0.f;
#pragma unroll
        for (int j = 0; j < 16; ++j) { v[j] = __builtin_nontemporal_load(xr + 64 * j); s += (v[j].x * v[j].x + v[j].y * v[j].y) + (v[j].z * v[j].z + v[j].w * v[j].w); }
        s = wave_sum(s);
#pragma unroll
        for (int j = 0; j < 16; ++j) { v2u w; w.x = pk2(v[j].x, v[j].y); w.y = pk2(v[j].z, v[j].w); o8[64 * j] = w; }
        if (F.lane == 0) RS1[m] = 1.0f / sqrtf(s * (1.f / DM) + EPS);
    }
}
__device__ __forceinline__ void phase_resid(Frame& F, const GAS float* gpost, GAS float* rs_out, GAS float* outf) {
    const int gw = F.vcu * NWAVES + F.wave, NGW = F.G * NWAVES; GAS bf16* X = (GAS bf16*)(F.ws + WS_XN); const GAS bf16* Y = (const GAS bf16*)(F.ws + WS_Y);
    for (int m = gw; m < M; m += NGW) {
        const GAS v2u* yr = (const GAS v2u*)(Y + (size_t)m * DM) + F.lane; GAS v2u* xr = (GAS v2u*)(X + (size_t)m * DM) + F.lane;
        const GAS f32x4* gp = (const GAS f32x4*)gpost + F.lane;
        f32x4 v[16]; float s = 0.f;
#pragma unroll
        for (int j = 0; j < 16; ++j) { const v2u w = yr[64 * j]; v[j] = (f32x4){bflo(w.x), bfhi(w.x), bflo(w.y), bfhi(w.y)}; s += (v[j].x * v[j].x + v[j].y * v[j].y) + (v[j].z * v[j].z + v[j].w * v[j].w); }
        const float rstd = 1.0f / sqrtf(wave_sum(s) * (1.f / DM) + EPS);
        float s2 = 0.f;
#pragma unroll
        for (int j = 0; j < 16; ++j) { const v2u w = xr[64 * j]; const f32x4 xx = (f32x4){bflo(w.x), bfhi(w.x), bflo(w.y), bfhi(w.y)}, gg = gp[64 * j]; v[j] = xx + v[j] * rstd * gg;
            s2 += (v[j].x * v[j].x + v[j].y * v[j].y) + (v[j].z * v[j].z + v[j].w * v[j].w); }
        if (outf) { GAS f32x4* xo = (GAS f32x4*)(outf + (size_t)m * DM) + F.lane;
#pragma unroll
            for (int j = 0; j < 16; ++j) xo[64 * j] = v[j]; }
        else {
#pragma unroll
            for (int j = 0; j < 16; ++j) { v2u w; w.x = pk2(v[j].x, v[j].y); w.y = pk2(v[j].z, v[j].w); xr[64 * j] = w; } }
        if (rs_out) { s2 = wave_sum(s2); if (F.lane == 0) rs_out[m] = 1.0f / sqrtf(s2 * (1.f / DM) + EPS); }
    }
}
__device__ __forceinline__ void phase_n2(Frame& F, int l) {
    const int gw = F.vcu * NWAVES + F.wave, NGW = F.G * NWAVES;
    const GAS bf16* H = (const GAS bf16*)(F.ws + WS_H); GAS bf16* CQN = (GAS bf16*)(F.ws + WS_CQN); GAS bf16* CKVN = (GAS bf16*)(F.ws + WS_CKVN); GAS bf16* KPE = (GAS bf16*)(F.ws + WS_KPE);
    const GAS float* qn = INP(5) + (size_t)l * 768; const GAS float* kvn = INP(6) + (size_t)l * 512; const GAS float* rope = (const GAS float*)(F.ws + WS_ROPE);
    for (int m = gw; m < M; m += NGW) {
        const GAS bf16* hr = H + (size_t)m * D_IN_PAD;
        { float x[12]; float s = 0.f;
#pragma unroll
          for (int j = 0; j < 3; ++j) { const v2u w = *(const GAS v2u*)(hr + OFF_CQ + 256 * j + 4 * F.lane); x[4 * j] = bflo(w.x); x[4 * j + 1] = bfhi(w.x); x[4 * j + 2] = bflo(w.y); x[4 * j + 3] = bfhi(w.y); }
#pragma unroll
          for (int j = 0; j < 12; ++j) s += x[j] * x[j];
          const float rstd = 1.0f / sqrtf(wave_sum(s) * (1.f / 768.f) + EPS);
#pragma unroll
          for (int j = 0; j < 3; ++j) { const f32x4 g = *(const GAS f32x4*)(qn + 256 * j + 4 * F.lane); v2u w; w.x = pk2(x[4 * j] * rstd * g.x, x[4 * j + 1] * rstd * g.y); w.y = pk2(x[4 * j + 2] * rstd * g.z, x[4 * j + 3] * rstd * g.w);
              *(GAS v2u*)(CQN + (size_t)m * 768 + 256 * j + 4 * F.lane) = w; } }
        { float x[8]; float s = 0.f;
#pragma unroll
          for (int j = 0; j < 2; ++j) { const v2u w = *(const GAS v2u*)(hr + OFF_CKV + 256 * j + 4 * F.lane); x[4 * j] = bflo(w.x); x[4 * j + 1] = bfhi(w.x); x[4 * j + 2] = bflo(w.y); x[4 * j + 3] = bfhi(w.y); }
#pragma unroll
          for (int j = 0; j < 8; ++j) s += x[j] * x[j];
          const float rstd = 1.0f / sqrtf(wave_sum(s) * (1.f / 512.f) + EPS);
#pragma unroll
          for (int j = 0; j < 2; ++j) { const f32x4 g = *(const GAS f32x4*)(kvn + 256 * j + 4 * F.lane); v2u w; w.x = pk2(x[4 * j] * rstd * g.x, x[4 * j + 1] * rstd * g.y); w.y = pk2(x[4 * j + 2] * rstd * g.z, x[4 * j + 3] * rstd * g.w);
              *(GAS v2u*)(CKVN + (size_t)m * 512 + 256 * j + 4 * F.lane) = w; } }
        if (F.lane < 32) { const int i = F.lane; const float t1 = bf2f(hr[OFF_KR + i]), t2 = bf2f(hr[OFF_KR + 32 + i]); const float c = rope[(size_t)m * 64 + 2 * i], sn = rope[(size_t)m * 64 + 2 * i + 1];
            *(GAS unsigned*)(KPE + (size_t)m * 64 + 2 * i) = pk2(t1 * c - t2 * sn, t1 * sn + t2 * c); }
    }
}

namespace att {
using bf16x8 = __attribute__((ext_vector_type(8))) short;
using s16x4  = __attribute__((ext_vector_type(4))) short;
using f32x16 = __attribute__((ext_vector_type(16))) float;
using u32x4  = __attribute__((ext_vector_type(4))) unsigned;
constexpr int SHM_V = 64 * 128 * 2, SHM_K = 64 * 272, SHM_KP = 64 * 144, QP_WAVE = 32 * 144;
constexpr int OFF_V = 0, OFF_K = 2 * SHM_V, OFF_KP = OFF_K + 2 * SHM_K, OFF_WS = OFF_KP + 2 * SHM_KP, OFF_QP = OFF_WS + 8 * 64 * 4, OFF_BIAS = OFF_QP + 8 * QP_WAVE, ATT_LDS = OFF_BIAS + 768 * 4;
constexpr float THR2 = 8.0f * 1.4426950408889634f;
#define KSWZ(row, colB) ((row) * 272 + (colB))
#define KPSWZ(row, colB) ((row) * 144 + (colB))
#define SBAR() __builtin_amdgcn_sched_barrier(0)
__device__ __forceinline__ int crow(int r, int hi) { return (r & 3) + 8 * (r >> 2) + 4 * hi; }
__device__ __forceinline__ unsigned cvtpk(float lo, float hi) { unsigned r; asm volatile("v_cvt_pk_bf16_f32 %0, %1, %2" : "=v"(r) : "v"(lo), "v"(hi)); return r; }
template <bool CA>
__device__ __forceinline__ void partialSM(f32x16& p0, f32x16& p1, float& m_reg, float& mn, float& alpha, bool masked, const float* ext, int xb) {
  if (masked) { for (int r = 0; r < 16; ++r) { p0[r] = -3e38f; p1[r] = -3e38f; } }
  else if constexpr (CA) {
    constexpr float C = 0.08838834764831845f * 1.4426950408889634f;
    for (int r = 0; r < 16; ++r) { const int ko = (r & 3) + 8 * (r >> 2); p0[r] = fmaf(p0[r], C, ext[xb - ko]); p1[r] = fmaf(p1[r], C, ext[xb - 32 - ko]); }
  }
  float pmax = p0[0]; for (int r = 1; r < 16; ++r) pmax = fmaxf(pmax, p0[r]); for (int r = 0; r < 16; ++r) pmax = fmaxf(pmax, p1[r]);
  { auto rr = __builtin_amdgcn_permlane32_swap(__float_as_uint(pmax), __float_as_uint(pmax), false, false);
    pmax = fmaxf(__uint_as_float(rr[0]), __uint_as_float(rr[1])); }
  if (__builtin_expect(__all(pmax - m_reg <= THR2), 1)) { mn = m_reg; alpha = 1.f; }
  else { mn = fmaxf(m_reg, pmax); alpha = __builtin_amdgcn_exp2f(m_reg - mn); m_reg = mn; }
  for (int r = 0; r < 16; ++r) p0[r] = p0[r] - mn; for (int r = 0; r < 16; ++r) p1[r] = p1[r] - mn;
  for (int r = 0; r < 16; ++r) p0[r] = __builtin_amdgcn_exp2f(p0[r]);
}
__device__ __forceinline__ void finishSM(f32x16& p0, f32x16& p1, float alpha, float& l_reg, bf16x8& pa0, bf16x8& pa1, bf16x8& pa2, bf16x8& pa3) {
  for (int r = 0; r < 16; ++r) p1[r] = __builtin_amdgcn_exp2f(p1[r]);
  float ps = 0; for (int r = 0; r < 16; ++r) ps += p0[r]; for (int r = 0; r < 16; ++r) ps += p1[r];
  { auto rr = __builtin_amdgcn_permlane32_swap(__float_as_uint(ps), __float_as_uint(ps), false, false);
    ps = __uint_as_float(rr[0]) + __uint_as_float(rr[1]); }
  l_reg = l_reg * alpha + ps;
#define PK4(P, BASE, OUT) do { unsigned a0 = cvtpk(P[BASE + 0], P[BASE + 1]), a1 = cvtpk(P[BASE + 2], P[BASE + 3]);   \
    unsigned b0 = cvtpk(P[BASE + 4], P[BASE + 5]), b1 = cvtpk(P[BASE + 6], P[BASE + 7]);                              \
    auto r0 = __builtin_amdgcn_permlane32_swap(a0, b0, false, false); auto r1 = __builtin_amdgcn_permlane32_swap(a1, b1, false, false); \
    u32x4 w = {r0[0], r1[0], r0[1], r1[1]}; OUT = *reinterpret_cast<bf16x8*>(&w); } while (0)
  PK4(p0, 0, pa0); PK4(p0, 8, pa1); PK4(p1, 0, pa2); PK4(p1, 8, pa3);
#undef PK4
}
template <int ND0>
__device__ __forceinline__ void qkt(f32x16& p0, f32x16& p1, const char* Ks, const char* Kps, const bf16x8* qr, const char* Qps, int r32, int hi) {
  p0 = f32x16{}; p1 = f32x16{};
#pragma unroll
  for (int d0 = 0; d0 < 8; ++d0) { const int cb = (d0 * 16 + hi * 8) * 2;
    bf16x8 b0 = *reinterpret_cast<const bf16x8*>(Ks + KSWZ(r32, cb));
    bf16x8 b1 = *reinterpret_cast<const bf16x8*>(Ks + KSWZ(32 + r32, cb));
    p0 = __builtin_amdgcn_mfma_f32_32x32x16_bf16(b0, qr[d0], p0, 0, 0, 0);
    p1 = __builtin_amdgcn_mfma_f32_32x32x16_bf16(b1, qr[d0], p1, 0, 0, 0); }
  if constexpr (ND0 > 8) {
#pragma unroll
    for (int d0 = 8; d0 < ND0; ++d0) { const int cb = ((d0 - 8) * 16 + hi * 8) * 2;
      bf16x8 b0 = *reinterpret_cast<const bf16x8*>(Kps + KPSWZ(r32, cb));
      bf16x8 b1 = *reinterpret_cast<const bf16x8*>(Kps + KPSWZ(32 + r32, cb));
      bf16x8 qv = *reinterpret_cast<const bf16x8*>(Qps + KPSWZ(r32, cb));
      p0 = __builtin_amdgcn_mfma_f32_32x32x16_bf16(b0, qv, p0, 0, 0, 0);
      p1 = __builtin_amdgcn_mfma_f32_32x32x16_bf16(b1, qv, p1, 0, 0, 0); }
  }
}
__device__ __forceinline__ int v_st(int k, int c) { const int kk = (k & ~0xC) | ((k & 4) << 1) | ((k & 8) >> 1); return ((kk >> 3) * 4 + (c >> 5)) * 512 + ((kk & 7) * 32 + (c & 31)) * 2; }
__device__ __forceinline__ int v_rd_base(int lane) { return ((lane & 3) << 3) | (((lane >> 2) & 3) << 6) | (((lane >> 4) & 1) << 5) | (((lane >> 5) & 1) << 8); }
constexpr int v_rd_off(int d0, int ks, int half) { return d0 * 512 + ks * 4096 + half * 2048; }
template <int OFF> __device__ __forceinline__ s16x4 tr_read(int vb) {
  s16x4 r; asm volatile("ds_read_b64_tr_b16 %0, %1 offset:%2" : "=&v"(r) : "v"(vb), "i"(OFF) : "memory"); return r;
}
template <int D0> __device__ __forceinline__ void pv_one(f32x16& od, int vb, bf16x8 pa0, bf16x8 pa1, bf16x8 pa2, bf16x8 pa3) {
  const s16x4 l0 = tr_read<v_rd_off(D0, 0, 0)>(vb), h0 = tr_read<v_rd_off(D0, 0, 1)>(vb), l1 = tr_read<v_rd_off(D0, 1, 0)>(vb), h1 = tr_read<v_rd_off(D0, 1, 1)>(vb);
  const s16x4 l2 = tr_read<v_rd_off(D0, 2, 0)>(vb), h2 = tr_read<v_rd_off(D0, 2, 1)>(vb), l3 = tr_read<v_rd_off(D0, 3, 0)>(vb), h3 = tr_read<v_rd_off(D0, 3, 1)>(vb);
  asm volatile("s_waitcnt lgkmcnt(0)" ::: "memory"); SBAR();
#define PK(L, H) (bf16x8){L[0], L[1], L[2], L[3], H[0], H[1], H[2], H[3]}
  od = __builtin_amdgcn_mfma_f32_32x32x16_bf16(pa0, PK(l0, h0), od, 0, 0, 0);
  od = __builtin_amdgcn_mfma_f32_32x32x16_bf16(pa1, PK(l1, h1), od, 0, 0, 0);
  od = __builtin_amdgcn_mfma_f32_32x32x16_bf16(pa2, PK(l2, h2), od, 0, 0, 0);
  od = __builtin_amdgcn_mfma_f32_32x32x16_bf16(pa3, PK(l3, h3), od, 0, 0, 0);
#undef PK
}
__device__ __forceinline__ void pv_d0(f32x16* o, int vb, bf16x8 pa0, bf16x8 pa1, bf16x8 pa2, bf16x8 pa3) {
  pv_one<0>(o[0], vb, pa0, pa1, pa2, pa3); pv_one<1>(o[1], vb, pa0, pa1, pa2, pa3); pv_one<2>(o[2], vb, pa0, pa1, pa2, pa3); pv_one<3>(o[3], vb, pa0, pa1, pa2, pa3);
}

#define AGAS __attribute__((address_space(1)))
template <bool CA>
__device__ __forceinline__ void attn_unit(const AGAS bf16* __restrict__ Qb, const AGAS bf16* __restrict__ Kn, const AGAS bf16* __restrict__ Kp, const AGAS bf16* __restrict__ Vh,
                                          AGAS bf16* __restrict__ Ob, int ldo, int qb, const AGAS float* __restrict__ bias_h, char* lds, int tid_in) {
  constexpr int LDQ = CA ? 8704 : 3072, LDK = CA ? 8704 : 2048, LDKP = 64, ND0 = CA ? 8 : 12, WIN = CA ? 8 : 100000;
  int tid = tid_in; asm volatile("" : "+v"(tid));
  const int wid = __builtin_amdgcn_readfirstlane(tid >> 6), lane = tid & 63, r32 = lane & 31, hi = lane >> 5;
  char* V_lds = lds + OFF_V; char* K_lds = lds + OFF_K; char* Kp_lds = lds + OFF_KP;
  float* ws = (float*)(lds + OFF_WS) + wid * 64; float* li_l = ws; float* al_l = ws + 32;
  float* ext = (float*)(lds + OFF_BIAS);
  float m_reg = -1e30f, l_reg = 0; f32x16 o[4] = {}; bf16x8 qr[8];
  char* Qp_lds = lds + OFF_QP + wid * QP_WAVE;
  const AGAS bf16* Qw = Qb + (long)(wid * 32 + r32) * LDQ + hi * 8;
#pragma unroll
  for (int d0 = 0; d0 < 8; ++d0) qr[d0] = *(const AGAS bf16x8*)(Qw + d0 * 16);
  const int sr = tid >> 4, sc = (tid & 15) * 8, vst0 = v_st(sr, sc), vst1 = v_st(32 + sr, sc);
  const int pr = tid >> 3, pc = (tid & 7) * 8;
  const int vb0 = (int)(uintptr_t)V_lds + v_rd_base(lane);
  const int cw = 4 * qb + (wid >> 1);
  const int tile0 = CA ? (4 * qb - 8 > 0 ? 4 * qb - 8 : 0) : 0, NT = 4 * qb + 4 - tile0;
  const int xq = 256 * qb + 32 * wid + r32 + 64 - 4 * hi;
  bf16x8 s_vs0, s_vs1, s_ks0, s_ks1, s_kp;
#define SLOAD(jt) do { const long k0_ = (long)(tile0 + (jt)) * 64; s_vs0 = *(const AGAS bf16x8*)(&Vh[(k0_ + sr) * LDK + sc]); s_vs1 = *(const AGAS bf16x8*)(&Vh[(k0_ + 32 + sr) * LDK + sc]); \
    s_ks0 = *(const AGAS bf16x8*)(&Kn[(k0_ + sr) * LDK + sc]); s_ks1 = *(const AGAS bf16x8*)(&Kn[(k0_ + 32 + sr) * LDK + sc]); \
    if constexpr (!CA) s_kp = *(const AGAS bf16x8*)(&Kp[(k0_ + pr) * LDKP + pc]); } while (0)
#define SWRITE(b) do { *(bf16x8*)(V_lds + (b) * SHM_V + vst0) = s_vs0; *(bf16x8*)(V_lds + (b) * SHM_V + vst1) = s_vs1; \
    *(bf16x8*)(K_lds + (b) * SHM_K + KSWZ(sr, sc * 2)) = s_ks0; *(bf16x8*)(K_lds + (b) * SHM_K + KSWZ(32 + sr, sc * 2)) = s_ks1; \
    if constexpr (!CA) *(bf16x8*)(Kp_lds + (b) * SHM_KP + KPSWZ(pr, pc * 2)) = s_kp; } while (0)
#define RESC(a) do { if (__any((a) < 1.f)) { if (hi == 0) al_l[r32] = (a); asm volatile("s_waitcnt lgkmcnt(0)" ::: "memory"); \
    for (int d = 0; d < 4; ++d) for (int r = 0; r < 16; ++r) o[d][r] *= al_l[crow(r, hi)]; } } while (0)
#define MASKED(jt) ((tile0 + (jt)) > cw || (tile0 + (jt)) < cw - WIN)
#define XB(jt) (xq - 64 * (tile0 + (jt)))
  f32x16 pA0, pA1, pB0, pB1; float mnA, mnB, alA, alB; bf16x8 pa0, pa1, pa2, pa3;
  __syncthreads();
  if constexpr (!CA) {
#pragma unroll
    for (int d = 0; d < 4; ++d) *(bf16x8*)(Qp_lds + KPSWZ(r32, (d * 16 + hi * 8) * 2)) = *(const AGAS bf16x8*)(Qw + 128 + d * 16);
  } else {
    for (int x = tid; x < 768; x += 512) { int d = x - 64; d = d < -256 ? -256 : (d > 256 ? 256 : d); ext[x] = bias_h[d + 256] * 1.4426950408889634f; }
  }
  SLOAD(0); asm volatile("s_waitcnt vmcnt(0)" ::: "memory"); SWRITE(0); __syncthreads();
  if (!MASKED(0)) qkt<ND0>(pA0, pA1, K_lds, Kp_lds, qr, Qp_lds, r32, hi);
  partialSM<CA>(pA0, pA1, m_reg, mnA, alA, MASKED(0), ext, XB(0));
  SLOAD(1);
  asm volatile("s_waitcnt vmcnt(0)" ::: "memory"); SWRITE(1); __syncthreads();
  for (int j = 1; j + 1 < NT; j += 2) {
    SBAR(); if (!MASKED(j)) qkt<ND0>(pB0, pB1, K_lds + SHM_K, Kp_lds + SHM_KP, qr, Qp_lds, r32, hi);
    finishSM(pA0, pA1, alA, l_reg, pa0, pa1, pa2, pa3); SBAR();
    SLOAD(j + 1); SBAR();
    if (!MASKED(j - 1)) pv_d0(o, vb0, pa0, pa1, pa2, pa3); partialSM<CA>(pB0, pB1, m_reg, mnB, alB, MASKED(j), ext, XB(j));
    __syncthreads(); asm volatile("s_waitcnt vmcnt(0)" ::: "memory"); SWRITE(0);
    RESC(alB); __syncthreads();
    SBAR(); if (!MASKED(j + 1)) qkt<ND0>(pA0, pA1, K_lds, Kp_lds, qr, Qp_lds, r32, hi);
    finishSM(pB0, pB1, alB, l_reg, pa0, pa1, pa2, pa3); SBAR();
    SLOAD(j + 2); SBAR();
    if (!MASKED(j)) pv_d0(o, vb0 + SHM_V, pa0, pa1, pa2, pa3); partialSM<CA>(pA0, pA1, m_reg, mnA, alA, MASKED(j + 1), ext, XB(j + 1));
    __syncthreads(); asm volatile("s_waitcnt vmcnt(0)" ::: "memory"); SWRITE(1);
    RESC(alA); __syncthreads();
  }
  SBAR(); if (!MASKED(NT - 1)) qkt<ND0>(pB0, pB1, K_lds + SHM_K, Kp_lds + SHM_KP, qr, Qp_lds, r32, hi);
  finishSM(pA0, pA1, alA, l_reg, pa0, pa1, pa2, pa3); SBAR();
  if (!MASKED(NT - 2)) pv_d0(o, vb0, pa0, pa1, pa2, pa3);
  partialSM<CA>(pB0, pB1, m_reg, mnB, alB, MASKED(NT - 1), ext, XB(NT - 1));
  __syncthreads(); RESC(alB);
  finishSM(pB0, pB1, alB, l_reg, pa0, pa1, pa2, pa3); SBAR();
  if (!MASKED(NT - 1)) pv_d0(o, vb0 + SHM_V, pa0, pa1, pa2, pa3);
  if (hi == 0) li_l[r32] = l_reg; asm volatile("s_waitcnt lgkmcnt(0)" ::: "memory");
  int lane2 = lane; asm volatile("" : "+v"(lane2));
  const int r32e = lane2 & 31, hie = lane2 >> 5;
  AGAS bf16* Ow = Ob + (long)(wid * 32) * ldo;
#pragma unroll
  for (int hh = 0; hh < 2; ++hh) {
#pragma unroll
    for (int r = 0; r < 16; ++r) { const int orow = crow(r, hie); const float rl = __builtin_amdgcn_rcpf(li_l[orow]);
#pragma unroll
      for (int dd = 0; dd < 2; ++dd) *(bf16*)(Qp_lds + orow * 128 + (dd * 32 + r32e) * 2) = (bf16)(cvtpk(o[2 * hh + dd][r] * rl, 0.f) & 0xffffu); }
    asm volatile("s_waitcnt lgkmcnt(0)" ::: "memory");
#pragma unroll
    for (int i = 0; i < 4; ++i) { const int v = lane2 + 64 * i, row = v >> 3, c16 = v & 7; *(AGAS u32x4*)(Ow + (long)row * ldo + 64 * hh + c16 * 8) = *(const u32x4*)(Qp_lds + row * 128 + c16 * 16); }
    asm volatile("s_waitcnt lgkmcnt(0)" ::: "memory");
  }
#undef SLOAD
#undef SWRITE
#undef RESC
#undef MASKED
#undef XB
}
}

namespace hg {
typedef short bf16x8 __attribute__((ext_vector_type(8)));
typedef float f32x4 __attribute__((ext_vector_type(4)));
constexpr int B_OFF = 0, KK_OFF = 32768, VT_OFF = 65536, QD_OFF = 83968, KT_OFF = 101376, P_OFF = 119808, TOT_OFF = 129024;
__device__ __forceinline__ unsigned short f2bf16(float x) { return (unsigned short)(pg8::cvt_pk_bf16(x, 0.f) & 0xffffu); }

__device__ __forceinline__ void hgrn_a_unit(Frame& F, int l, int u) {
    int t = F.tid; asm volatile("" : "+v"(t));
    const int c = u & 127, bh = u >> 7, b = bh >> 3, h = bh & 7;
    const int s = t >> 7, k = t & 127, lane = t & 63, wave = F.wave, lr = lane & 15, lq = lane >> 4;
    const size_t m0 = (size_t)b * SEQ + 64 * c;
    const GAS bf16* Hb = (const GAS bf16*)(F.ws + WS_H) + m0 * D_IN_PAD + h * 128 + k;
    LAS float* Bs = (LAS float*)(F.lds + B_OFF); LAS float* KK = (LAS float*)(F.lds + KK_OFF); LAS float* TOT = (LAS float*)(F.lds + TOT_OFF);
    LAS bf16* VT = (LAS bf16*)(F.lds + VT_OFF); LAS bf16* QD = (LAS bf16*)(F.lds + QD_OFF); LAS bf16* KT = (LAS bf16*)(F.lds + KT_OFF); LAS bf16* P = (LAS bf16*)(F.lds + P_OFF);
    const float lb = ((const GAS float*)(F.ws + WS_LB))[l * 1024 + h * 128 + k];
    GAS float* MR = (GAS float*)(F.ws + WS_MIXRAW); GAS bf16* ST = (GAS bf16*)(F.ws + WS_ST) + (size_t)u * 16384; GAS bf16* QG = (GAS bf16*)(F.ws + WS_QG); GAS float* DL = (GAS float*)(F.ws + WS_DL) + (size_t)u * 128;
    __syncthreads();
    float breg[16]; unsigned qraw[16]; float run = 0.f;
#pragma unroll
    for (int i = 0; i < 16; ++i) { const int tok = 16 * s + i; const GAS bf16* hr = Hb + (size_t)tok * D_IN_PAD;
        const float fp = bf2f(hr[OFF_HF]); qraw[i] = hr[OFF_HQ]; VT[k * 72 + tok] = hr[OFF_HI];
        const float f = lb + (1.0f - lb) * __builtin_amdgcn_rcpf(1.0f + __expf(-fp));
        KK[tok * 128 + k] = (1.0f - lb) * __builtin_amdgcn_rcpf(1.0f + __expf(fp));
        run += __logf(fmaxf(f, 1e-30f)); breg[i] = run; }
    TOT[s * 128 + k] = run;
    __syncthreads();
    const float t0 = TOT[k], t1 = TOT[128 + k], t2 = TOT[256 + k], t3 = TOT[384 + k];
    const float off = (s > 0 ? t0 : 0.f) + (s > 1 ? t1 : 0.f) + (s > 2 ? t2 : 0.f);
#pragma unroll
    for (int i = 0; i < 16; ++i) { const int tok = 16 * s + i; const float qv = bf2f(qraw[i]); const float qh = qv * __builtin_amdgcn_rcpf(1.0f + __expf(-qv));
        Bs[tok * 128 + k] = breg[i] + off; QD[tok * 136 + k] = f2bf16(qh * __expf(breg[i]));
        { const float qg = qh * __expf(breg[i] + off), other = __shfl_xor(qg, 1); if ((k & 1) == 0) *(GAS unsigned*)(QG + (m0 + tok) * 1024 + h * 128 + k) = pk2(qg, other); } }
    const float b63 = (t0 + t1) + (t2 + t3);
    if (s == 3) DL[k] = __expf(b63);
    __syncthreads();
#pragma unroll 1
    for (int a = 0; a < 4; ++a) {
        const float ca = (a > 0 ? t0 : 0.f) + (a > 1 ? t1 : 0.f) + (a > 2 ? t2 : 0.f);
        for (int r = 0; r < 4 * (a + 1); ++r) { const int j = s + 4 * r; KT[j * 136 + k] = f2bf16(KK[j * 128 + k] * __expf(fminf(ca - Bs[j * 128 + k], 80.f))); }
        __syncthreads();
        if (wave < 4) {
            f32x4 acc = (f32x4){0.f, 0.f, 0.f, 0.f};
            if (wave <= a) {
#pragma unroll
                for (int ks = 0; ks < 4; ++ks) { const bf16x8 af = *(const LAS bf16x8*)(QD + (16 * a + lr) * 136 + 32 * ks + 8 * lq), bfr = *(const LAS bf16x8*)(KT + (16 * wave + lr) * 136 + 32 * ks + 8 * lq);
                    acc = __builtin_amdgcn_mfma_f32_16x16x32_bf16(af, bfr, acc, 0, 0, 0); }
            }
#pragma unroll
            for (int reg = 0; reg < 4; ++reg) { const int i = 4 * lq + reg, j = lr; float pv = acc[reg]; if (wave == a && j > i) pv = 0.f; P[(16 * a + i) * 72 + 16 * wave + j] = f2bf16(pv); }
        }
        __syncthreads();
    }
    LAS bf16* KET = KT;
#pragma unroll 4
    for (int r = 0; r < 16; ++r) { const int j = s + 4 * r; KET[k * 72 + j] = f2bf16(KK[j * 128 + k] * __expf(b63 - Bs[j * 128 + k])); }
    __syncthreads();
    {
        bf16x8 vb[2];
#pragma unroll
        for (int ks = 0; ks < 2; ++ks) vb[ks] = *(const LAS bf16x8*)(VT + (16 * wave + lr) * 72 + 32 * ks + 8 * lq);
#pragma unroll
        for (int rb = 0; rb < 4; ++rb) { f32x4 acc = (f32x4){0.f, 0.f, 0.f, 0.f};
#pragma unroll
            for (int ks = 0; ks < 2; ++ks) { const bf16x8 af = *(const LAS bf16x8*)(P + (16 * rb + lr) * 72 + 32 * ks + 8 * lq); acc = __builtin_amdgcn_mfma_f32_16x16x32_bf16(af, vb[ks], acc, 0, 0, 0); }
#pragma unroll
            for (int reg = 0; reg < 4; ++reg) MR[(m0 + 16 * rb + 4 * lq + reg) * DM + 2048 + h * 128 + 16 * wave + lr] = acc[reg]; }
#pragma unroll
        for (int kb = 0; kb < 8; ++kb) { f32x4 acc = (f32x4){0.f, 0.f, 0.f, 0.f};
#pragma unroll
            for (int ks = 0; ks < 2; ++ks) { const bf16x8 bfr = *(const LAS bf16x8*)(KET + (16 * kb + lr) * 72 + 32 * ks + 8 * lq); acc = __builtin_amdgcn_mfma_f32_16x16x32_bf16(vb[ks], bfr, acc, 0, 0, 0); }
#pragma unroll
            for (int reg = 0; reg < 4; ++reg) { const float other = __shfl_xor(acc[reg], 1); if ((lr & 1) == 0) *(GAS unsigned*)(ST + (16 * wave + 4 * lq + reg) * 128 + 16 * kb + lr) = pk2(acc[reg], other); } }
    }
}
__device__ __forceinline__ void phase_hgrn_a(Frame& F, int l) { for (int u = F.vcu; u < 2048; u += F.G) hgrn_a_unit(F, l, u); __syncthreads(); }

__device__ __forceinline__ void phase_hgrn_b(Frame& F) {
    typedef float f32x2 __attribute__((ext_vector_type(2)));
    GAS bf16* STb = (GAS bf16*)(F.ws + WS_ST); const GAS float* DL = (const GAS float*)(F.ws + WS_DL);
    for (int idx = F.vcu * 512 + F.tid; idx < 16 * 8192; idx += F.G * 512) {
        const int chain = idx >> 13, e = (idx & 8191) * 2, k = e & 127; const size_t u0 = (size_t)chain * 128;
        f32x2 sv = (f32x2){0.f, 0.f};
#pragma unroll 1
        for (int c0 = 0; c0 < 128; c0 += 8) {
            unsigned tmp[8]; f32x2 d[8];
#pragma unroll
            for (int j = 0; j < 8; ++j) { tmp[j] = *(const GAS unsigned*)(STb + (u0 + c0 + j) * 16384 + e); d[j] = *(const GAS f32x2*)(DL + (u0 + c0 + j) * 128 + k); }
#pragma unroll
            for (int j = 0; j < 8; ++j) { *(GAS unsigned*)(STb + (u0 + c0 + j) * 16384 + e) = pk2(sv.x, sv.y); sv = d[j] * sv + (f32x2){bflo(tmp[j]), bfhi(tmp[j])}; }
        }
    }
}
__device__ __forceinline__ void hgrn_c_unit(Frame& F, int u) {
    int t = F.tid; asm volatile("" : "+v"(t));
    const int c = u & 127, bh = u >> 7, b = bh >> 3, h = bh & 7;
    const int lane = t & 63, wave = F.wave, lr = lane & 15, lq = lane >> 4;
    const size_t m0 = (size_t)b * SEQ + 64 * c;
    LAS bf16* QGs = (LAS bf16*)(F.lds); LAS bf16* STs = (LAS bf16*)(F.lds + 17408);
    GAS float* MR = (GAS float*)(F.ws + WS_MIXRAW); const GAS bf16* ST = (const GAS bf16*)(F.ws + WS_ST) + (size_t)u * 16384; const GAS bf16* QG = (const GAS bf16*)(F.ws + WS_QG);
    __syncthreads();
#pragma unroll
    for (int r = 0; r < 2; ++r) { const int v = t + 512 * r, row = v >> 4, cv = v & 15; *(LAS v4u*)(QGs + row * 136 + cv * 8) = *(const GAS v4u*)(QG + (m0 + row) * 1024 + h * 128 + cv * 8); }
#pragma unroll
    for (int r = 0; r < 4; ++r) { const int v = t + 512 * r, row = v >> 4, cv = v & 15; *(LAS v4u*)(STs + row * 136 + cv * 8) = *(const GAS v4u*)(ST + row * 128 + cv * 8); }
    __syncthreads();
    bf16x8 bfr[4];
#pragma unroll
    for (int ks = 0; ks < 4; ++ks) bfr[ks] = *(const LAS bf16x8*)(STs + (16 * wave + lr) * 136 + 32 * ks + 8 * lq);
#pragma unroll
    for (int rb = 0; rb < 4; ++rb) { f32x4 acc = (f32x4){0.f, 0.f, 0.f, 0.f};
#pragma unroll
        for (int ks = 0; ks < 4; ++ks) { const bf16x8 af = *(const LAS bf16x8*)(QGs + (16 * rb + lr) * 136 + 32 * ks + 8 * lq); acc = __builtin_amdgcn_mfma_f32_16x16x32_bf16(af, bfr[ks], acc, 0, 0, 0); }
#pragma unroll
        for (int reg = 0; reg < 4; ++reg) { GAS float* p = MR + (m0 + 16 * rb + 4 * lq + reg) * DM + 2048 + h * 128 + 16 * wave + lr; *p += acc[reg]; } }
}
__device__ __forceinline__ void phase_hgrn_c(Frame& F) { for (int u = F.vcu; u < 2048; u += F.G) { if ((u & 127) != 0) hgrn_c_unit(F, u); } __syncthreads(); }
}

__device__ __forceinline__ void phase_mixers(Frame& F, int l, unsigned char* lds_generic) {
    const GAS bf16* H = (const GAS bf16*)(F.ws + WS_H); const GAS bf16* Q = (const GAS bf16*)(F.ws + WS_Q); const GAS bf16* KN = (const GAS bf16*)(F.ws + WS_KN); const GAS bf16* V = (const GAS bf16*)(F.ws + WS_V); const GAS bf16* KPE = (const GAS bf16*)(F.ws + WS_KPE);
    GAS bf16* MA = (GAS bf16*)(F.ws + WS_MIXRAW);
    hg::phase_hgrn_c(F);
    for (int p = F.vcu; p < 512; p += F.G) { const int bh = p >> 4, i = p & 15, b = bh >> 4, h = bh & 15; const size_t r0 = (size_t)b * SEQ;
_Pragma("unroll 1")
        for (int half = 0; half < 2; ++half) { const int qb = half ? i : 31 - i;
            att::attn_unit<false>(Q + (r0 + 256 * qb) * 3072 + h * 192, KN + r0 * 2048 + h * 128, KPE + r0 * 64, V + r0 * 2048 + h * 128, MA + (r0 + 256 * qb) * 8192 + h * 128, 8192, qb, nullptr, (char*)lds_generic, F.tid); } }
    __syncthreads();
    const GAS float* rb = INP(12) + (size_t)l * 8 * 513;
    for (int p = F.vcu; p < 512; p += F.G) { const int qb = 31 - (p >> 4), bh = p & 15, b = bh >> 3, h = bh & 7; const size_t r0 = (size_t)b * SEQ; const GAS bf16* hb = H + r0 * D_IN_PAD + h * 128;
        att::attn_unit<true>(hb + (size_t)(256 * qb) * D_IN_PAD + OFF_AQ, hb + OFF_AK, nullptr, hb + OFF_AV, MA + (r0 + 256 * qb) * 8192 + 2048 + h * 128, 8192, qb, rb + h * 513, (char*)lds_generic, F.tid); }
    __syncthreads();
}
__device__ __forceinline__ void phase_mixnorm(Frame& F, int l) {
    const int gw = F.vcu * NWAVES + F.wave, NGW = F.G * NWAVES;
    const GAS float* MR = (const GAS float*)(F.ws + WS_MIXRAW); const GAS bf16* H = (const GAS bf16*)(F.ws + WS_H); GAS bf16* MIX = (GAS bf16*)(F.ws + WS_MIX);
    const GAS float* g_mla = INP(9) + (size_t)l * 2048; const GAS float* g_hg = INP(11) + (size_t)l * 1024; const GAS float* g_ca = INP(13) + (size_t)l * 1024;
    for (int m = gw; m < M; m += NGW) {
        const GAS float* r = MR + (size_t)m * DM; GAS bf16* o = MIX + (size_t)m * DM;
        const GAS bf16* ra = (const GAS bf16*)(F.ws + WS_MIXRAW) + (size_t)m * 8192;
        { f32x4 v[8]; float s = 0.f;
#pragma unroll
          for (int j = 0; j < 8; ++j) { const v2u w = *(const GAS v2u*)(ra + 256 * j + 4 * F.lane); v[j] = (f32x4){bflo(w.x), bfhi(w.x), bflo(w.y), bfhi(w.y)}; s += (v[j].x * v[j].x + v[j].y * v[j].y) + (v[j].z * v[j].z + v[j].w * v[j].w); }
          const float rstd = 1.0f / sqrtf(wave_sum(s) * (1.f / 2048.f) + EPS);
#pragma unroll
          for (int j = 0; j < 8; ++j) { const f32x4 g = *(const GAS f32x4*)(g_mla + 256 * j + 4 * F.lane); v2u w; w.x = pk2(v[j].x * rstd * g.x, v[j].y * rstd * g.y); w.y = pk2(v[j].z * rstd * g.z, v[j].w * rstd * g.w);
              *(GAS v2u*)(o + 256 * j + 4 * F.lane) = w; } }
        { f32x4 v[4];
#pragma unroll
          for (int j = 0; j < 4; ++j) { v[j] = *(const GAS f32x4*)(r + 2048 + 256 * j + 4 * F.lane); float s = (v[j].x * v[j].x + v[j].y * v[j].y) + (v[j].z * v[j].z + v[j].w * v[j].w);
              s += __shfl_xor(s, 1); s += __shfl_xor(s, 2); s += __shfl_xor(s, 4); s += __shfl_xor(s, 8); s += __shfl_xor(s, 16);
              const float rstd = 1.0f / sqrtf(s * (1.f / 128.f) + EPS);
              const f32x4 g = *(const GAS f32x4*)(g_hg + 256 * j + 4 * F.lane); const v2u gw2 = *(const GAS v2u*)(H + (size_t)m * D_IN_PAD + OFF_HG + 256 * j + 4 * F.lane);
              const float g0 = bflo(gw2.x), g1 = bfhi(gw2.x), g2 = bflo(gw2.y), g3 = bfhi(gw2.y);
              v2u w; w.x = pk2(v[j].x * rstd * g.x * (g0 * __builtin_amdgcn_rcpf(1.0f + __expf(-g0))), v[j].y * rstd * g.y * (g1 * __builtin_amdgcn_rcpf(1.0f + __expf(-g1)))); w.y = pk2(v[j].z * rstd * g.z * (g2 * __builtin_amdgcn_rcpf(1.0f + __expf(-g2))), v[j].w * rstd * g.w * (g3 * __builtin_amdgcn_rcpf(1.0f + __expf(-g3))));
              *(GAS v2u*)(o + 2048 + 256 * j + 4 * F.lane) = w; } }
        { f32x4 v[4]; float s = 0.f;
#pragma unroll
          for (int j = 0; j < 4; ++j) { const v2u w = *(const GAS v2u*)(ra + 2048 + 256 * j + 4 * F.lane); v[j] = (f32x4){bflo(w.x), bfhi(w.x), bflo(w.y), bfhi(w.y)}; s += (v[j].x * v[j].x + v[j].y * v[j].y) + (v[j].z * v[j].z + v[j].w * v[j].w); }
          const float rstd = 1.0f / sqrtf(wave_sum(s) * (1.f / 1024.f) + EPS);
#pragma unroll
          for (int j = 0; j < 4; ++j) { const f32x4 g = *(const GAS f32x4*)(g_ca + 256 * j + 4 * F.lane); v2u w; w.x = pk2(v[j].x * rstd * g.x, v[j].y * rstd * g.y); w.y = pk2(v[j].z * rstd * g.z, v[j].w * rstd * g.w);
              *(GAS v2u*)(o + 3072 + 256 * j + 4 * F.lane) = w; } }
    }
}

template <int l>
__device__ __forceinline__ void layer_phases(Frame& F, const XcdBarrier& bar, const int lo, const int hi, unsigned char* lds) {
#define IN(k) (lo <= (k) && (k) < hi)
#define SEAM(k) do { if (IN(k) && IN((k) + 1)) xcd_barrier(bar); } while (0)
#define FRESH() do { int t_ = F.wave * 64 + lane_id(); asm volatile("" : "+v"(t_)); F.tid = t_; F.lane = t_ & 63; asm volatile("" : "+s"(F.ws)); } while (0)
        const int pb = 1 + 10 * l;
        if (IN(pb + 0)) { FRESH(); { pg8::Gemm g{(const GAS bf16*)(F.ws + WS_XN), (const GAS bf16*)(F.ws + WS_WIN), M, D_IN_PAD, DM}; pg8::StaticOrder S; S.init(M, D_IN_PAD, F.G, (int)blockIdx.x);
            pg8::EpiH E{(GAS bf16*)(F.ws + WS_H), D_IN_PAD, (const GAS float*)(F.ws + WS_RS1)};
            pg8::gemm_phase<pg8::EpiH, pg8::StaticOrder, true, true>(F.lds + RING_OFF, g, S, E, F.tid); } }
        SEAM(pb + 0);
        if (IN(pb + 1)) { FRESH(); phase_n2(F, l); hg::phase_hgrn_a(F, l); }
        SEAM(pb + 1);
        if (IN(pb + 2)) { FRESH();
            { pg8::Gemm g{(const GAS bf16*)(F.ws + WS_CQN), (const GAS bf16*)(F.ws + WS_WUQ), M, 3072, 768}; pg8::StaticOrder S; S.init(M, 3072, F.G, (int)blockIdx.x);
              pg8::EpiQ E{(GAS bf16*)(F.ws + WS_Q), (const GAS float*)(F.ws + WS_ROPE), 0.07216878364870322f * LOG2E};
              pg8::gemm_phase<pg8::EpiQ, pg8::StaticOrder, true, true>(F.lds + RING_OFF, g, S, E, F.tid); }
            __syncthreads();
            { pg8::Gemm g{(const GAS bf16*)(F.ws + WS_CKVN), (const GAS bf16*)(F.ws + WS_WUKV), M, 4096, 512}; pg8::StaticOrder S; S.init(M, 4096, F.G, (int)blockIdx.x);
              pg8::EpiKV E{(GAS bf16*)(F.ws + WS_KN), (GAS bf16*)(F.ws + WS_V)};
              pg8::gemm_phase<pg8::EpiKV, pg8::StaticOrder, true, true>(F.lds + RING_OFF, g, S, E, F.tid); }
            __syncthreads();
            hg::phase_hgrn_b(F);
        }
        SEAM(pb + 2);
        if (IN(pb + 3)) { FRESH(); phase_mixers(F, l, lds); }
        SEAM(pb + 3);
        if (IN(pb + 4)) { FRESH(); phase_mixnorm(F, l); }
        SEAM(pb + 4);
        if (IN(pb + 5)) { FRESH(); { pg8::Gemm g{(const GAS bf16*)(F.ws + WS_MIX), (const GAS bf16*)(F.ws + WS_WOUT), M, DM, DM}; pg8::StaticOrder S; S.init(M, DM, F.G, (int)blockIdx.x);
            pg8::EpiH E{(GAS bf16*)(F.ws + WS_Y), DM, nullptr};
            pg8::gemm_phase<pg8::EpiH, pg8::StaticOrder, true, true>(F.lds + RING_OFF, g, S, E, F.tid); } }
        SEAM(pb + 5);
        if (IN(pb + 6)) { FRESH(); phase_resid(F, INP(3) + (size_t)l * DM, (GAS float*)(F.ws + WS_RS2), (GAS float*)nullptr); }
        SEAM(pb + 6);
        if (IN(pb + 7)) { FRESH(); { pg8::Gemm g{(const GAS bf16*)(F.ws + WS_XN), (const GAS bf16*)(F.ws + WS_WGU), M, 2 * DFF, DM}; pg8::StaticOrder S; S.init(M, 2 * DFF, F.G, (int)blockIdx.x);
            pg8::EpiSwiGLU E{(GAS bf16*)(F.ws + WS_ACT), DFF, (const GAS float*)(F.ws + WS_RS2)};
            pg8::gemm_phase<pg8::EpiSwiGLU, pg8::StaticOrder, true, true>(F.lds + RING_OFF, g, S, E, F.tid); } }
        SEAM(pb + 7);
        if (IN(pb + 8)) { FRESH(); { pg8::Gemm g{(const GAS bf16*)(F.ws + WS_ACT), (const GAS bf16*)(F.ws + WS_WD), M, DM, DFF}; pg8::StaticOrder S; S.init(M, DM, F.G, (int)blockIdx.x);
            pg8::EpiH E{(GAS bf16*)(F.ws + WS_Y), DM, nullptr};
            pg8::gemm_phase<pg8::EpiH, pg8::StaticOrder, true, true>(F.lds + RING_OFF, g, S, E, F.tid); } }
        SEAM(pb + 8);
        if (IN(pb + 9)) { FRESH(); { CArgs ap = argp(); phase_resid(F, (const GAS float*)ap->in[16] + (size_t)l * DM, (l + 1 < DEPTH) ? (GAS float*)(F.ws + WS_RS1) : (GAS float*)nullptr, (l + 1 < DEPTH) ? (GAS float*)nullptr : (GAS float*)ap->out); }
            if (l + 1 < DEPTH) convert_weights(F, l + 1); }
        SEAM(pb + 9);
#undef IN
#undef SEAM
#undef FRESH
}
__global__ void __launch_bounds__(NWAVES * 64, 2) mk_fwd(Args args) {
    extern __shared__ __attribute__((aligned(16))) unsigned char lds[];
    Frame F;
    F.lds = (LAS unsigned char*)lds;
    F.MISC = (volatile LAS unsigned*)(F.lds + MISC_OFF);
    F.tid = threadIdx.x; F.lane = F.tid & 63; F.wave = __builtin_amdgcn_readfirstlane(F.tid >> 6);
    F.G = gridDim.x; { const int bx = blockIdx.x; F.vcu = (F.G % 8 == 0) ? (bx % 8) * (F.G / 8) + bx / 8 : bx; }
    F.ws = (GAS unsigned char*)args.ws; F.ctl = (gu32*)(F.ws + WS_CTL);
    for (int u = F.tid; u < (LDS_BYTES - LDSCTL_OFF) / 4; u += NWAVES * 64) ((LAS unsigned*)(F.lds + LDSCTL_OFF))[u] = 0u;
    __syncthreads();
    XcdBarrier bar = xcd_barrier_post((unsigned*)(F.ctl + CW_BAR) + args.li * XCD_BAR_WORDS, F.MISC + 8, F.wave);
    const int lo = args.ph_lo, hi = args.ph_hi;
#define IN(k) (lo <= (k) && (k) < hi)
#define FRESH() do { int t_ = F.wave * 64 + lane_id(); asm volatile("" : "+v"(t_)); F.tid = t_; F.lane = t_ & 63; asm volatile("" : "+s"(F.ws)); } while (0)
#define SEAM(k) do { if (IN(k) && IN((k) + 1)) xcd_barrier(bar); } while (0)

    if (IN(0)) { FRESH(); convert_weights(F, 0); make_tables(F); phase_n1(F, INP(0)); }
    SEAM(0);
    layer_phases<0>(F, bar, lo, hi, lds);
    layer_phases<1>(F, bar, lo, hi, lds);
#undef IN
#undef FRESH
#undef SEAM
}

extern "C" void kernel_launch(void* const* d_in, const int* in_sizes, int n_in, void* d_out, int out_size, void* d_ws, size_t ws_size, hipStream_t stream) {
    static int grid = 0;
    if (grid == 0) {
        if (n_in != 20 || in_sizes[0] != M * DM || out_size != M * DM || ws_size < WS_END) { fprintf(stderr, "kernel_launch: shape/workspace mismatch (n_in %d, in0 %d, out %d, ws %zu, need %zu)\n", n_in, n_in > 0 ? in_sizes[0] : -1, out_size, ws_size, (size_t)WS_END); grid = -1; return; }
        int dev = 0, cus = 0, per_cu = 0;
        if (hipGetDevice(&dev) != hipSuccess || hipDeviceGetAttribute(&cus, hipDeviceAttributeMultiprocessorCount, dev) != hipSuccess) { grid = -1; return; }
        if (hipFuncSetAttribute((const void*)mk_fwd, hipFuncAttributeMaxDynamicSharedMemorySize, LDS_BYTES) != hipSuccess) { fprintf(stderr, "kernel_launch: hipFuncSetAttribute failed\n"); grid = -1; return; }
        if (hipOccupancyMaxActiveBlocksPerMultiprocessor(&per_cu, (const void*)mk_fwd, NWAVES * 64, LDS_BYTES) != hipSuccess || per_cu < 1) fprintf(stderr, "kernel_launch: occupancy query says %d\n", per_cu);
        (void)hipGetLastError();
        grid = cus;
    }
    if (grid < 0) return;
    if (hipMemsetAsync((char*)d_ws + WS_CTL, 0, CTL_ZERO_BYTES, stream) != hipSuccess) return;
    Args a{};
    for (int i = 0; i < 20; ++i) a.in[i] = (const float*)d_in[i];
    a.out = (float*)d_out; a.ws = (unsigned char*)d_ws; a.pad = 0;
#if MK_PER_PHASE
    for (int p = 0; p < NPH; ++p) { a.ph_lo = p; a.ph_hi = p + 1; a.li = p;
        hipLaunchKernelGGL(mk_fwd, dim3(grid), dim3(NWAVES * 64), LDS_BYTES, stream, a); }
#else
    a.ph_lo = 0; a.ph_hi = NPH; a.li = 0;
    hipLaunchKernelGGL(mk_fwd, dim3(grid), dim3(NWAVES * 64), LDS_BYTES, stream, a);
#endif
    const hipError_t le = hipPeekAtLastError();
    if (le != hipSuccess) fprintf(stderr, "kernel_launch: launch failed: %s\n", hipGetErrorName(le));
}
```
